# Optimizing an MI355X kernel written in HIP

```python
import jax, jax.numpy as jnp
from jax import lax
import numpy as np

D_MODEL = 1024
BATCH = 16
SEQ = 2048
DEPTH = 2

PLE_DIM = 256
ATT_HEADS = 8
ATT_KV_HEADS = 2
HEAD_DIM = 64
Q_RANK = 256
IDX_HEADS = 8
IDX_DIM = 64
TOPK_MAX = 256
Q_BLOCK = 128
ML_HEADS = 4
ML_DIM = 128
CONV_W = 4
CHUNK = 64
D_FF = 4 * D_MODEL
ROPE_THETA = 500000.0
ROT_DIM = HEAD_DIM // 4
EPS = 1e-6

ATT_W = ATT_HEADS * HEAD_DIM
KV_W = ATT_KV_HEADS * HEAD_DIM
ML_W = ML_HEADS * ML_DIM
MIX_W = ATT_W + ML_W
IN_SIZES = (Q_RANK, KV_W, KV_W, IDX_DIM, IDX_HEADS, ML_W, ML_W, ML_W, ML_W, ML_HEADS, ML_HEADS)
IN_W = sum(IN_SIZES)
IDX_SCALE = (IDX_HEADS ** -0.5) * (IDX_DIM ** -0.5)

kernel_name = "hybrid_dsa_mlstm_parallel_heads"


def rms_norm(x, g):
    xf = x.astype(jnp.float32)
    y = xf * lax.rsqrt(jnp.mean(xf * xf, axis=-1, keepdims=True) + EPS)
    return (y * g.astype(jnp.float32)).astype(x.dtype)


def rope_tables(positions):
    half = ROT_DIM // 2
    inv = ROPE_THETA ** (-(jnp.arange(half, dtype=jnp.float32) * 2.0) / ROT_DIM)
    ang = positions.astype(jnp.float32)[..., None] * inv
    return jnp.cos(ang), jnp.sin(ang)


def apply_partial_rope(x, cos, sin):
    half = ROT_DIM // 2
    c = cos[:, :, None, :].astype(x.dtype)
    s = sin[:, :, None, :].astype(x.dtype)
    x1 = x[..., :half]
    x2 = x[..., half:ROT_DIM]
    return jnp.concatenate([x1 * c - x2 * s, x2 * c + x1 * s, x[..., ROT_DIM:]], axis=-1)


def causal_dwconv(x, w, b):
    S = x.shape[1]
    xp = jnp.pad(x, ((0, 0), (CONV_W - 1, 0), (0, 0)))
    acc = xp[:, 0:S] * w[0]
    for j in range(1, CONV_W):
        acc = acc + xp[:, j:j + S] * w[j]
    return acc + b


def dsa_attention(q, k, v, q_idx, k_idx, w_idx):
    B, S, H, D = q.shape
    G = H // ATT_KV_HEADS
    n_sel = min(TOPK_MAX, S // 4)
    nb = S // Q_BLOCK
    key_pos = jnp.arange(S)
    scale = D ** -0.5

    def blk(a):
        return a.reshape(B, nb, Q_BLOCK, *a.shape[2:]).swapaxes(0, 1)

    def one_block(args):
        qb, qib, wb, qpos = args
        logits = jnp.einsum('bqhd,bsd->bqhs', qib, k_idx)
        score = jnp.einsum('bqh,bqhs->bqs', wb, jax.nn.relu(logits)).astype(jnp.float32)
        causal = key_pos[None, :] <= qpos[:, None]
        score = jnp.where(causal[None], score, -jnp.inf)
        _, sel = lax.top_k(score, n_sel)
        k_sel = jax.vmap(lambda kb, ib: kb[ib])(k, sel)
        v_sel = jax.vmap(lambda vb, ib: vb[ib])(v, sel)
        valid = sel <= qpos[None, :, None]
        qg = qb.reshape(B, Q_BLOCK, ATT_KV_HEADS, G, D)
        s = jnp.einsum('bqgrd,bqkgd->bqgrk', qg, k_sel).astype(jnp.float32) * scale
        s = jnp.where(valid[:, :, None, None, :], s, -jnp.inf)
        pr = jax.nn.softmax(s, axis=-1).astype(v.dtype)
        o = jnp.einsum('bqgrk,bqkgd->bqgrd', pr, v_sel)
        return o.reshape(B, Q_BLOCK, H, D)

    out = lax.map(one_block, (blk(q), blk(q_idx), blk(w_idx), key_pos.reshape(nb, Q_BLOCK)))
    return out.swapaxes(0, 1).reshape(B, S, H, D)


def mlstm_chunkwise(q, k, v, i_pre, f_pre):
    B, S, H, D = q.shape
    nc = S // CHUNK
    f32 = jnp.float32
    qf = q.astype(f32) * (D ** -0.5)
    kf = k.astype(f32)
    vf = v.astype(f32)
    log_f = jax.nn.log_sigmoid(f_pre.astype(f32))
    log_i = i_pre.astype(f32)

    def chunks(a):
        a = a.reshape(B, nc, CHUNK, H, *a.shape[3:])
        return jnp.moveaxis(a, (1, 3), (0, 2))

    tri = jnp.tril(jnp.ones((CHUNK, CHUNK), dtype=bool))

    def step(carry, xs):
        C, n, m = carry
        qc, kc, vc, lic, lfc = xs
        b = jnp.cumsum(lfc, axis=-1)
        log_d = b[..., :, None] - b[..., None, :] + lic[..., None, :]
        log_d = jnp.where(tri, log_d, -jnp.inf)
        inter = b + m[..., None]
        m_t = jnp.maximum(inter, jnp.max(log_d, axis=-1))
        dmat = jnp.exp(log_d - m_t[..., None])
        inter_w = jnp.exp(inter - m_t)
        qk = jnp.einsum('bhtd,bhsd->bhts', qc, kc) * dmat
        num = inter_w[..., None] * jnp.einsum('bhtd,bhde->bhte', qc, C) + jnp.einsum('bhts,bhse->bhte', qk, vc)
        den = inter_w * jnp.einsum('bhtd,bhd->bht', qc, n) + jnp.sum(qk, axis=-1)
        h = num / jnp.maximum(jnp.abs(den), jnp.exp(-m_t))[..., None]
        b_last = b[..., -1]
        log_g = b_last[..., None] - b + lic
        m_new = jnp.maximum(b_last + m, jnp.max(log_g, axis=-1))
        g = jnp.exp(log_g - m_new[..., None])
        decay = jnp.exp(b_last + m - m_new)
        C_new = decay[..., None, None] * C + jnp.einsum('bhs,bhsd,bhse->bhde', g, kc, vc)
        n_new = decay[..., None] * n + jnp.einsum('bhs,bhsd->bhd', g, kc)
        return (C_new, n_new, m_new), h

    init = (jnp.zeros((B, H, D, D), f32), jnp.zeros((B, H, D), f32), jnp.zeros((B, H), f32))
    _, hs = lax.scan(step, init, (chunks(qf), chunks(kf), chunks(vf), chunks(log_i), chunks(log_f)))
    hs = jnp.moveaxis(hs, (0, 2), (1, 3)).reshape(B, S, H, D)
    return hs.astype(q.dtype)


def hybrid_layer(h, p_i, cos, sin, g_mix, w_in, g_cq, w_q_up, w_iq_up, g_qn, g_kn, g_ik,
                 conv_w, conv_b, i_bias, f_bias, g_mh, w_out, g_mlp, w_ff1, w_ff2,
                 g_ple, w_ple_gate, b_ple_gate, w_ple):
    B, S, _ = h.shape
    xn = rms_norm(h, g_mix)
    proj = xn @ w_in
    split_at = np.cumsum(IN_SIZES)[:-1].tolist()
    c_q, a_k, a_v, i_k, i_w, m_q, m_k, m_v, m_o, m_i, m_f = jnp.split(proj, split_at, axis=-1)

    c_q = rms_norm(c_q, g_cq)
    a_q = (c_q @ w_q_up).reshape(B, S, ATT_HEADS, HEAD_DIM)
    i_q = (c_q @ w_iq_up).reshape(B, S, IDX_HEADS, IDX_DIM)
    a_q = apply_partial_rope(rms_norm(a_q, g_qn), cos, sin)
    a_k = apply_partial_rope(rms_norm(a_k.reshape(B, S, ATT_KV_HEADS, HEAD_DIM), g_kn), cos, sin)
    a_v = a_v.reshape(B, S, ATT_KV_HEADS, HEAD_DIM)
    i_q = apply_partial_rope(i_q, cos, sin)
    i_k = apply_partial_rope(rms_norm(i_k, g_ik)[:, :, None, :], cos, sin)[:, :, 0, :]
    i_w = i_w * IDX_SCALE
    att = dsa_attention(a_q, a_k, a_v, i_q, i_k, i_w).reshape(B, S, ATT_W)

    qk = jax.nn.silu(causal_dwconv(jnp.concatenate([m_q, m_k], axis=-1), conv_w, conv_b))
    m_q, m_k = qk[..., :ML_W], qk[..., ML_W:]
    hm = mlstm_chunkwise(m_q.reshape(B, S, ML_HEADS, ML_DIM), m_k.reshape(B, S, ML_HEADS, ML_DIM),
                         m_v.reshape(B, S, ML_HEADS, ML_DIM), m_i + i_bias, m_f + f_bias)
    hm = (jax.nn.sigmoid(m_o) * rms_norm(hm, g_mh).reshape(B, S, ML_W))

    h = h + jnp.concatenate([att, hm], axis=-1) @ w_out

    u = rms_norm(h, g_mlp) @ w_ff1
    h = h + jnp.square(jax.nn.relu(u)) @ w_ff2

    gate = jax.nn.sigmoid(rms_norm(h, g_ple) @ w_ple_gate + b_ple_gate)
    return h + gate * (p_i @ w_ple)


def setup_inputs(seed: int = 0) -> dict:
    key = jax.random.key(seed)
    ks = iter(jax.random.split(key, 32))
    f32 = jnp.float32

    def nrm(shape, scale):
        return jax.random.normal(next(ks), shape, f32) * scale

    def gain(shape):
        return 1.0 + nrm(shape, 0.02)

    L = DEPTH
    x = nrm((BATCH, SEQ, D_MODEL), 1.0)
    p = nrm((L, BATCH, SEQ, PLE_DIM), 1.0)
    offs = jax.random.randint(next(ks), (BATCH, 1), 0, 4096, dtype=jnp.int32)
    positions = jnp.arange(SEQ, dtype=jnp.int32)[None, :] + offs
    return {
        "x": x,
        "p": p,
        "positions": positions,
        "g_mix": gain((L, D_MODEL)),
        "w_in": nrm((L, D_MODEL, IN_W), D_MODEL ** -0.5),
        "g_cq": gain((L, Q_RANK)),
        "w_q_up": nrm((L, Q_RANK, ATT_W), Q_RANK ** -0.5),
        "w_iq_up": nrm((L, Q_RANK, IDX_HEADS * IDX_DIM), Q_RANK ** -0.5),
        "g_qn": gain((L, HEAD_DIM)),
        "g_kn": gain((L, HEAD_DIM)),
        "g_ik": gain((L, IDX_DIM)),
        "conv_w": nrm((L, CONV_W, 2 * ML_W), CONV_W ** -0.5),
        "conv_b": nrm((L, 2 * ML_W), 0.01),
        "i_bias": nrm((L, ML_HEADS), 0.1),
        "f_bias": jnp.linspace(3.0, 6.0, ML_HEADS, dtype=f32)[None, :] + nrm((L, ML_HEADS), 0.1),
        "g_mh": gain((L, ML_HEADS, ML_DIM)),
        "w_out": nrm((L, MIX_W, D_MODEL), MIX_W ** -0.5),
        "g_mlp": gain((L, D_MODEL)),
        "w_ff1": nrm((L, D_MODEL, D_FF), D_MODEL ** -0.5),
        "w_ff2": nrm((L, D_FF, D_MODEL), D_FF ** -0.5),
        "g_ple": gain((L, D_MODEL)),
        "w_ple_gate": nrm((L, D_MODEL, D_MODEL), D_MODEL ** -0.5),
        "b_ple_gate": nrm((L, D_MODEL), 0.01),
        "w_ple": nrm((L, PLE_DIM, D_MODEL), PLE_DIM ** -0.5),
    }


def reference(x, p, positions, g_mix, w_in, g_cq, w_q_up, w_iq_up, g_qn, g_kn, g_ik,
              conv_w, conv_b, i_bias, f_bias, g_mh, w_out, g_mlp, w_ff1, w_ff2,
              g_ple, w_ple_gate, b_ple_gate, w_ple):
    cos, sin = rope_tables(positions)
    h = x
    for i in range(DEPTH):
        h = hybrid_layer(h, p[i], cos, sin, g_mix[i], w_in[i], g_cq[i], w_q_up[i], w_iq_up[i],
                         g_qn[i], g_kn[i], g_ik[i], conv_w[i], conv_b[i], i_bias[i], f_bias[i],
                         g_mh[i], w_out[i], g_mlp[i], w_ff1[i], w_ff2[i], g_ple[i],
                         w_ple_gate[i], b_ple_gate[i], w_ple[i])
    return h
```

```cpp
#include <hip/hip_runtime.h>
#include <cstdint>
#include <cstdio>
#include <cmath>
#include <hip/hip_cooperative_groups.h>
namespace cg = cooperative_groups;

constexpr int DM = 1024, BATCH = 16, SEQ = 2048, DEPTH = 2, M = BATCH * SEQ;
constexpr int PLE = 256, QR = 256, TOPK = 256, DFF = 4096, IN_W = 2640;
constexpr int C_CQ = 0, C_AK = 256, C_AV = 384, C_IK = 512, C_IW = 576, C_MQ = 584, C_MK = 1096, C_MV = 1608, C_MO = 2120, C_MI = 2632, C_MF = 2636;
constexpr float EPS = 1e-6f;
constexpr float IDX_SCALE = 0.04419417382415922f;
constexpr float QSCALE = 0.125f * 1.4426950408889634f;
constexpr float MLQ_SCALE = 0.08838834764831845f;

typedef uint16_t bf16_t;
__device__ __forceinline__ float bf2f(bf16_t v) { return __uint_as_float(((unsigned)v) << 16); }
__device__ __forceinline__ bf16_t f2bf(float f) { unsigned u = __float_as_uint(f); return (bf16_t)((u + 0x7fffu + ((u >> 16) & 1u)) >> 16); }

constexpr size_t MiB = 1u << 20;
constexpr size_t WS_HB = 0;
constexpr size_t WS_SS = 64 * MiB;
constexpr size_t WS_ROPE = 70 * MiB;
constexpr size_t WS_CQ = 72 * MiB;
constexpr size_t WS_CQSS = 88 * MiB;
constexpr size_t WS_IW = 89 * MiB;
constexpr size_t WS_MI = 90 * MiB;
constexpr size_t WS_MF = 91 * MiB;
constexpr size_t WS_K = 92 * MiB;
constexpr size_t WS_VT = 100 * MiB;
constexpr size_t WS_IK = 108 * MiB;
constexpr size_t WS_SEL = 112 * MiB;
constexpr size_t WS_Q = 120 * MiB;
constexpr size_t WS_IQ = 152 * MiB;
constexpr size_t WS_MQ = 184 * MiB;
constexpr size_t WS_MK = 216 * MiB;
constexpr size_t WS_MV = 248 * MiB;
constexpr size_t WS_MO = 280 * MiB;
constexpr size_t WS_PW0 = 72 * MiB;
constexpr size_t WS_PW1 = 472 * MiB;
constexpr int PW_SPLIT_PM = 96;
constexpr size_t WS_PB = 440 * MiB;
constexpr size_t WS_U = 120 * MiB;
constexpr size_t WS_END = 488 * MiB;

struct Bufs {
    bf16_t *HB, *CQ, *K, *VT, *IK, *Q, *IQ, *MQ, *MK, *MV, *MO, *MIX, *PW0, *PW1, *PB, *U;
    float *SS, *ROPE, *CQSS, *IW, *MI, *MF; unsigned* SEL;
};

__device__ __forceinline__ float wave_sum(float v) {
#pragma unroll
    for (int o = 1; o < 64; o <<= 1) v += __shfl_xor(v, o);
    return v;
}
__device__ __forceinline__ float sigmoidf_(float x) { return 1.f / (1.f + __expf(-x)); }
__device__ __forceinline__ float logsigmoidf_(float x) { return fminf(x, 0.f) - log1pf(__expf(-fabsf(x))); }
__device__ __forceinline__ float rs_from_ss(const float* ss16) {
    float s = 0.f;
#pragma unroll
    for (int i = 0; i < 16; ++i) s += ss16[i];
    return rsqrtf(s * (1.f / 1024.f) + EPS);
}

__device__ __forceinline__ unsigned f2ord(float f) { const unsigned u = __float_as_uint(f); return (u & 0x80000000u) ? ~u : (u | 0x80000000u); }

#define LAS __attribute__((address_space(3)))
typedef short bf16x8 __attribute__((ext_vector_type(8)));
typedef float f32x4 __attribute__((ext_vector_type(4)));
typedef float f32x2 __attribute__((ext_vector_type(2)));
typedef unsigned u32x4 __attribute__((ext_vector_type(4)));
typedef unsigned u32x2 __attribute__((ext_vector_type(2)));

constexpr int NWAVES = 8, NTHREADS = 512;
constexpr int LDS_BYTES = 147456;

constexpr size_t WS_W = 376 * MiB, W_LSTRIDE = 28 * MiB;
constexpr size_t WO_IN = 0, WO_QUP = 6 * MiB, WO_OUT = 7 * MiB, WO_F1 = 9 * MiB, WO_F2 = 17 * MiB, WO_G = 25 * MiB, WO_P = 27 * MiB;
constexpr size_t WS_CTL = 432 * MiB;
constexpr int NPROJ = 2816;

__device__ __forceinline__ unsigned cvt_pk_bf16(float lo, float hi) { unsigned r; asm volatile("v_cvt_pk_bf16_f32 %0, %1, %2" : "=v"(r) : "v"(lo), "v"(hi)); return r; }
__device__ __forceinline__ u32x4 pack8(const f32x4 a, const f32x4 b) { u32x4 w; w.x = cvt_pk_bf16(a[0], a[1]); w.y = cvt_pk_bf16(a[2], a[3]); w.z = cvt_pk_bf16(b[0], b[1]); w.w = cvt_pk_bf16(b[2], b[3]); return w; }
__device__ __forceinline__ u32x2 pack4(const f32x4 a) { u32x2 w; w.x = cvt_pk_bf16(a[0], a[1]); w.y = cvt_pk_bf16(a[2], a[3]); return w; }
__device__ __forceinline__ float dot4(const f32x4 a) { return (a[0] * a[0] + a[1] * a[1]) + (a[2] * a[2] + a[3] * a[3]); }
__device__ __forceinline__ float red_fq(float s) { s += __shfl_xor(s, 16); s += __shfl_xor(s, 32); return s; }
__device__ __forceinline__ float fast_sigmoid(float x) { return __builtin_amdgcn_rcpf(1.f + __builtin_amdgcn_exp2f(-1.4426950408889634f * x)); }
__device__ __forceinline__ f32x4 sig4(const f32x4 v) { f32x4 o; o[0] = fast_sigmoid(v[0]); o[1] = fast_sigmoid(v[1]); o[2] = fast_sigmoid(v[2]); o[3] = fast_sigmoid(v[3]); return o; }
__host__ __device__ __forceinline__ int dimmap(int pos) { return pos < 16 ? ((pos & 3) | ((pos & 4) << 1) | ((pos & 8) >> 1)) : pos; }

namespace pg8 {
constexpr int BM = 256, BK = 64, HALF = 128, HTB = HALF * BK * 2, STAGE_BYTES = 8 * HTB, NXCD = 8, WGM = 8;
__host__ __device__ __forceinline__ int lds_byte(int r, int c) { const int st = (r >> 4) * 2 + (c >> 5), rr = r & 15, cc = c & 31, ob = rr * 64 + cc * 2; return st * 1024 + (ob ^ (((ob >> 9) & 1) << 5)); }
__host__ __device__ __forceinline__ void stage_rc(int b, int& R, int& C) { const int st = b / 1024, sb = b % 1024, swz = sb ^ (((sb >> 9) & 1) << 5); R = (st >> 1) * 16 + swz / 64; C = (st & 1) * 32 + (swz % 64) / 2; }
__host__ __device__ __forceinline__ int perm32(int rho) { const int n = rho >> 4, i = rho & 15; return 8 * (i >> 2) + 4 * n + (i & 3); }
struct Unit { int pm, pn; };
struct Gemm { const bf16_t* A; const bf16_t* Bt; int M, N, K; };
struct StaticOrder {
    int nM, nN, nwg, G, c; bool rev = false;
    __host__ __device__ void init(int M_, int N_, int G_, int c_) { nM = M_ / BM; nN = N_ / BM; nwg = nM * nN; G = G_; c = c_; }
    __host__ __device__ bool next(int i, Unit& u) const {
        const long L = (long)i * G + c; if (L >= nwg) return false;
        int wgid = (int)L; { const int q = nwg / NXCD, r = nwg % NXCD, xcd = wgid % NXCD, off = wgid / NXCD; wgid = (xcd < r ? xcd * (q + 1) : r * (q + 1) + (xcd - r) * q) + off; }
        const int nig = WGM * nN, gid = wgid / nig, fm = gid * WGM, gsz = (nM - fm) < WGM ? (nM - fm) : WGM;
        u.pm = fm + ((wgid % nig) % gsz); u.pn = (wgid % nig) / gsz; if (rev) u.pm ^= 15; return true;
    }
};
template <class Epi, bool A_TILED = false>
__device__ __forceinline__ void gemm_phase(LAS unsigned char* lds, const Gemm g, const StaticOrder& S, const Epi& E, const int wave_id) {
    int tid_ = wave_id * 64 + (int)__lane_id(); asm volatile("" : "+v"(tid_));
    const int tid = tid_, wid = __builtin_amdgcn_readfirstlane(tid >> 6), lane = tid & 63, wr = wid >> 2, wc = wid & 3, fr = lane & 15, fq = lane >> 4;
    const int K = g.K, nt = K / BK;
    unsigned voffA[2], voffB[2];
#pragma unroll
    for (int i = 0; i < 2; ++i) { int R, C; stage_rc(tid * 16 + i * 8192, R, C); const int Rb = (R & ~31) + perm32(R & 31);
        voffA[i] = (unsigned)(R * K + C) * 2u; voffB[i] = (unsigned)(Rb * K + C) * 2u;
        if (A_TILED) { const int st = (tid * 16 + i * 8192) >> 10; voffA[i] = (unsigned)((((st >> 1) * (K >> 5) + (st & 1)) << 10) + ((tid * 16) & 1023)); } }
    const size_t kstep = A_TILED ? (size_t)2048 : (size_t)(BK * 2), kstepB = (size_t)(BK * 2);
    const size_t hstep = (size_t)HALF * K * 2;
    const size_t tstep = 2 * hstep;
    const unsigned ldsw = (unsigned)wid * 1024u;
    const int aoff = lds_byte(wr * 64 + fr, fq * 8), boff = lds_byte(wc * 32 + fr, fq * 8);
#define PG8_SA(b, h) (((b) * 2 + (h)) * HTB)
#define PG8_SB(b, h) ((4 + (b) * 2 + (h)) * HTB)
#define PG8_STAGE(bufoff, gbase, voff) do { _Pragma("unroll") for (int _i = 0; _i < 2; ++_i) \
        __builtin_amdgcn_global_load_lds((const unsigned*)((const char*)(gbase) + (voff)[_i]), (LAS unsigned*)(lds + (bufoff) + ldsw + _i * 8192), 16, 0, 0); } while (0)
#define PG8_LDA(dst, b, h) do { _Pragma("unroll") for (int m = 0; m < 4; ++m) _Pragma("unroll") for (int k = 0; k < 2; ++k) dst[m][k] = *(const LAS bf16x8*)(lds + PG8_SA(b, h) + aoff + m * 2048 + k * 1024); } while (0)
#define PG8_LDB(dst, b, h) do { _Pragma("unroll") for (int n = 0; n < 2; ++n) _Pragma("unroll") for (int k = 0; k < 2; ++k) dst[n][k] = *(const LAS bf16x8*)(lds + PG8_SB(b, h) + boff + n * 2048 + k * 1024); } while (0)
#define PG8_MMA(ai, bj, At, Bt) do { __builtin_amdgcn_s_setprio(1); _Pragma("unroll") for (int m = 0; m < 4; ++m) _Pragma("unroll") for (int n = 0; n < 2; ++n) _Pragma("unroll") for (int k = 0; k < 2; ++k) \
        acc[ai][bj][m][n] = __builtin_amdgcn_mfma_f32_16x16x32_bf16(Bt[n][k], At[m][k], acc[ai][bj][m][n], 0, 0, 0); __builtin_amdgcn_s_setprio(0); } while (0)
#define PG8_WAIT_V(n) asm volatile("s_waitcnt vmcnt(" #n ")" ::: "memory")
#define PG8_WAIT_L(n) asm volatile("s_waitcnt lgkmcnt(" #n ")" ::: "memory")
#define PG8_BAR __builtin_amdgcn_s_barrier()
#define PG8_SCHED __builtin_amdgcn_sched_barrier(0)
    Unit cur, nxt; int ui = 0;
    if (!S.next(0, cur)) return;
    typename Epi::Pre pre;
    f32x4 acc[2][2][4][2];
#pragma unroll
    for (int a = 0; a < 2; ++a)
#pragma unroll
        for (int b = 0; b < 2; ++b)
#pragma unroll
            for (int m = 0; m < 4; ++m)
#pragma unroll
                for (int n = 0; n < 2; ++n) acc[a][b][m][n] = (f32x4){0.f, 0.f, 0.f, 0.f};
    bf16x8 At[4][2], B0[2][2], B1[2][2];
    const char* cA = (const char*)g.A + (size_t)cur.pm * tstep; const char* cB = (const char*)g.Bt + (size_t)cur.pn * tstep;
    PG8_STAGE(PG8_SB(0, 0), cB, voffB); PG8_STAGE(PG8_SB(0, 1), cB + hstep, voffB); PG8_STAGE(PG8_SA(0, 0), cA, voffA); PG8_STAGE(PG8_SA(0, 1), cA + hstep, voffA);
    if (wr == 1) PG8_BAR;
    PG8_WAIT_V(2); PG8_BAR;
    PG8_STAGE(PG8_SB(1, 0), cB + kstepB, voffB); PG8_STAGE(PG8_SA(1, 0), cA + kstep, voffA); PG8_STAGE(PG8_SB(1, 1), cB + hstep + kstepB, voffB);
    PG8_WAIT_V(6); PG8_BAR;
    for (;;) {
        const bool has_next = S.next(ui + 1, nxt);
        const char* nA = has_next ? (const char*)g.A + (size_t)nxt.pm * tstep : cA; const char* nB = has_next ? (const char*)g.Bt + (size_t)nxt.pn * tstep : cB;
        for (int t = 0; t < nt; t += 2) {
            const bool last = (t == nt - 2);
            if (last) E.prefetch(pre, cur, wr, wc, fr, fq);
            const char* a1 = cA + (size_t)(t + 1) * kstep;
            const char* a2 = last ? nA : cA + (size_t)(t + 2) * kstep; const char* b2 = last ? nB : cB + (size_t)(t + 2) * kstepB;
            const char* a3 = a2 + kstep; const char* b3 = b2 + kstepB;
            PG8_LDB(B0, 0, 0); PG8_LDB(B1, 0, 1); PG8_SCHED; PG8_LDA(At, 0, 0); PG8_STAGE(PG8_SA(1, 1), a1 + hstep, voffA);
            PG8_WAIT_V(8); PG8_WAIT_L(0); PG8_BAR; PG8_MMA(0, 0, At, B0); PG8_MMA(0, 1, At, B1); PG8_BAR; PG8_SCHED;
            PG8_LDA(At, 0, 1); PG8_STAGE(PG8_SB(0, 0), b2, voffB); PG8_STAGE(PG8_SB(0, 1), b2 + hstep, voffB); PG8_STAGE(PG8_SA(0, 0), a2, voffA);
            PG8_WAIT_V(8); PG8_WAIT_L(0); PG8_BAR; PG8_MMA(1, 0, At, B0); PG8_MMA(1, 1, At, B1); PG8_BAR; PG8_SCHED;
            PG8_LDB(B0, 1, 0); PG8_LDB(B1, 1, 1); PG8_SCHED; PG8_LDA(At, 1, 0); PG8_STAGE(PG8_SA(0, 1), a2 + hstep, voffA);
            PG8_WAIT_V(8); PG8_WAIT_L(0); PG8_BAR; PG8_MMA(0, 0, At, B0); PG8_MMA(0, 1, At, B1); PG8_BAR; PG8_SCHED;
            PG8_LDA(At, 1, 1); PG8_STAGE(PG8_SB(1, 0), b3, voffB); PG8_STAGE(PG8_SB(1, 1), b3 + hstep, voffB); PG8_STAGE(PG8_SA(1, 0), a3, voffA);
            PG8_WAIT_V(8); PG8_WAIT_L(0); PG8_BAR; PG8_MMA(1, 0, At, B0); PG8_MMA(1, 1, At, B1); PG8_BAR; PG8_SCHED;
        }
        if (wr == 0) PG8_BAR;
        E(acc, cur, wr, wc, fr, fq, pre);
        if (!has_next) break;
#pragma unroll
        for (int a = 0; a < 2; ++a)
#pragma unroll
            for (int b = 0; b < 2; ++b)
#pragma unroll
                for (int m = 0; m < 4; ++m)
#pragma unroll
                    for (int n = 0; n < 2; ++n) acc[a][b][m][n] = (f32x4){0.f, 0.f, 0.f, 0.f};
        cur = nxt; cA = nA; cB = nB; ++ui;
        if (wr == 1) PG8_BAR;
    }
    PG8_WAIT_V(0);
    PG8_BAR;
#undef PG8_SA
#undef PG8_SB
#undef PG8_STAGE
#undef PG8_LDA
#undef PG8_LDB
#undef PG8_MMA
#undef PG8_WAIT_V
#undef PG8_WAIT_L
#undef PG8_BAR
#undef PG8_SCHED
}
}
typedef f32x4 Acc[2][2][4][2];

__device__ __forceinline__ float row_rs16(const float* SS, int row, int fq) {
    const f32x4 s4 = *(const f32x4*)(SS + (size_t)row * 16 + 4 * fq);
    return rsqrtf(red_fq((s4[0] + s4[1]) + (s4[2] + s4[3])) * (1.f / 1024.f) + EPS);
}
__device__ __forceinline__ void rs4_load(const float* SS, int rowbase, int fq, float (&rs)[4]) {
    f32x4 s4[4];
#pragma unroll
    for (int m = 0; m < 4; ++m) s4[m] = *(const f32x4*)(SS + (size_t)(rowbase + 16 * m) * 16 + 4 * fq);
#pragma unroll
    for (int m = 0; m < 4; ++m) rs[m] = rsqrtf(red_fq((s4[m][0] + s4[m][1]) + (s4[m][2] + s4[m][3])) * (1.f / 1024.f) + EPS);
}
__device__ __forceinline__ void rs2_load(const float* SS, int rowbase, int fq, float (&rs)[2]) {
    f32x4 s4[2];
#pragma unroll
    for (int m = 0; m < 2; ++m) s4[m] = *(const f32x4*)(SS + (size_t)(rowbase + 16 * m) * 16 + 4 * fq);
#pragma unroll
    for (int m = 0; m < 2; ++m) rs[m] = rsqrtf(red_fq((s4[m][0] + s4[m][1]) + (s4[m][2] + s4[m][3])) * (1.f / 1024.f) + EPS);
}
#define EPI_FENCE() asm volatile("" ::: "memory")

struct EpiRes {
    const float* hin; float* out; bf16_t* HB; float* SSo;
    struct Pre {}; __device__ __forceinline__ void prefetch(Pre&, const pg8::Unit&, int, int, int, int) const {}
    __device__ __forceinline__ void operator()(const Acc& acc, const pg8::Unit& u, int wr, int wc, int fr, int fq, const Pre&) const {
        const int row0 = u.pm * 256 + wr * 64 + fr, col0 = u.pn * 256 + wc * 32 + 8 * fq;
#pragma unroll
        for (int ai = 0; ai < 2; ++ai) {
            f32x4 h[4][2][2];
#pragma unroll
            for (int m = 0; m < 4; ++m)
#pragma unroll
                for (int bj = 0; bj < 2; ++bj) { const size_t off = (size_t)(row0 + ai * 128 + m * 16) * DM + col0 + bj * 128; h[m][bj][0] = *(const f32x4*)(hin + off); h[m][bj][1] = *(const f32x4*)(hin + off + 4); }
#pragma unroll
            for (int m = 0; m < 4; ++m) { const int row = row0 + ai * 128 + m * 16; float sq = 0.f;
#pragma unroll
                for (int bj = 0; bj < 2; ++bj) { const size_t off = (size_t)row * DM + col0 + bj * 128;
                    const f32x4 x0 = h[m][bj][0] + acc[ai][bj][m][0], x1 = h[m][bj][1] + acc[ai][bj][m][1];
                    *(f32x4*)(out + off) = x0; *(f32x4*)(out + off + 4) = x1; *(u32x4*)(HB + off) = pack8(x0, x1); sq += dot4(x0) + dot4(x1); }
                sq = red_fq(sq); if (fq == 0) SSo[(size_t)row * 16 + u.pn * 4 + wc] = sq; }
            EPI_FENCE(); }
    }
};
__device__ __forceinline__ void bf8_unpack(const u32x4 pw, f32x4& p0, f32x4& p1) {
    p0[0] = __uint_as_float(pw.x << 16); p0[1] = __uint_as_float(pw.x & 0xffff0000u); p0[2] = __uint_as_float(pw.y << 16); p0[3] = __uint_as_float(pw.y & 0xffff0000u);
    p1[0] = __uint_as_float(pw.z << 16); p1[1] = __uint_as_float(pw.z & 0xffff0000u); p1[2] = __uint_as_float(pw.w << 16); p1[3] = __uint_as_float(pw.w & 0xffff0000u);
}
template <bool IN_F32> struct EpiResB {
    const void* hin; bf16_t* HBo; float* SSo;
    struct Pre {}; __device__ __forceinline__ void prefetch(Pre&, const pg8::Unit&, int, int, int, int) const {}
    __device__ __forceinline__ void operator()(const Acc& acc, const pg8::Unit& u, int wr, int wc, int fr, int fq, const Pre&) const {
        const int row0 = u.pm * 256 + wr * 64 + fr, col0 = u.pn * 256 + wc * 32 + 8 * fq;
        if (IN_F32) {
#pragma unroll
            for (int ai = 0; ai < 2; ++ai) {
                f32x4 h[4][2][2];
#pragma unroll
                for (int m = 0; m < 4; ++m)
#pragma unroll
                    for (int bj = 0; bj < 2; ++bj) { const size_t off = (size_t)(row0 + ai * 128 + m * 16) * DM + col0 + bj * 128; h[m][bj][0] = *(const f32x4*)((const float*)hin + off); h[m][bj][1] = *(const f32x4*)((const float*)hin + off + 4); }
#pragma unroll
                for (int m = 0; m < 4; ++m) { const int row = row0 + ai * 128 + m * 16; float sq = 0.f;
#pragma unroll
                    for (int bj = 0; bj < 2; ++bj) { const size_t off = (size_t)row * DM + col0 + bj * 128;
                        const f32x4 x0 = h[m][bj][0] + acc[ai][bj][m][0], x1 = h[m][bj][1] + acc[ai][bj][m][1];
                        *(u32x4*)(HBo + off) = pack8(x0, x1); sq += dot4(x0) + dot4(x1); }
                    sq = red_fq(sq); if (fq == 0) SSo[(size_t)row * 16 + u.pn * 4 + wc] = sq; }
                EPI_FENCE(); }
        } else {
            u32x4 hp[2][4][2];
#pragma unroll
            for (int ai = 0; ai < 2; ++ai)
#pragma unroll
                for (int m = 0; m < 4; ++m)
#pragma unroll
                    for (int bj = 0; bj < 2; ++bj) hp[ai][m][bj] = *(const u32x4*)((const bf16_t*)hin + (size_t)(row0 + ai * 128 + m * 16) * DM + col0 + bj * 128);
#pragma unroll
            for (int ai = 0; ai < 2; ++ai)
#pragma unroll
                for (int m = 0; m < 4; ++m) { const int row = row0 + ai * 128 + m * 16; float sq = 0.f;
#pragma unroll
                    for (int bj = 0; bj < 2; ++bj) { const size_t off = (size_t)row * DM + col0 + bj * 128;
                        f32x4 h0, h1; bf8_unpack(hp[ai][m][bj], h0, h1);
                        const f32x4 x0 = h0 + acc[ai][bj][m][0], x1 = h1 + acc[ai][bj][m][1];
                        *(u32x4*)(HBo + off) = pack8(x0, x1); sq += dot4(x0) + dot4(x1); }
                    sq = red_fq(sq); if (fq == 0) SSo[(size_t)row * 16 + u.pn * 4 + wc] = sq; }
        }
    }
};
struct EpiFF1 {
    const float* SS; bf16_t* U;
    struct Pre { float ps[8]; };
    __device__ __forceinline__ void prefetch(Pre& p, const pg8::Unit& u, int wr, int wc, int fr, int fq) const {
        const int row0 = u.pm * 256 + wr * 64 + fr;
#pragma unroll
        for (int i = 0; i < 8; ++i) { const f32x4 s4 = *(const f32x4*)(SS + (size_t)(row0 + (i >> 2) * 128 + (i & 3) * 16) * 16 + 4 * fq); p.ps[i] = (s4[0] + s4[1]) + (s4[2] + s4[3]); }
    }
    __device__ __forceinline__ void operator()(const Acc& acc, const pg8::Unit& u, int wr, int wc, int fr, int fq, const Pre& p) const {
        const int row0 = u.pm * 256 + wr * 64 + fr, col0 = u.pn * 256 + wc * 32 + 8 * fq;
#pragma unroll
        for (int ai = 0; ai < 2; ++ai) {
#pragma unroll
            for (int m = 0; m < 4; ++m) { const int row = row0 + ai * 128 + m * 16; const float rs = rsqrtf(red_fq(p.ps[ai * 4 + m]) * (1.f / 1024.f) + EPS);
#pragma unroll
                for (int bj = 0; bj < 2; ++bj) { f32x4 a = acc[ai][bj][m][0] * rs, b = acc[ai][bj][m][1] * rs;
#pragma unroll
                    for (int j = 0; j < 4; ++j) { a[j] = fmaxf(a[j], 0.f); a[j] *= a[j]; b[j] = fmaxf(b[j], 0.f); b[j] *= b[j]; }
                    const int row16 = row >> 4, col32 = (u.pn * 256 + bj * 128 + wc * 32) >> 5, ob = fr * 64 + 16 * fq;
                    *(u32x4*)((char*)U + (((size_t)row16 * (DFF >> 5) + col32) << 10) + (ob ^ (((ob >> 9) & 1) << 5))) = pack8(a, b); } }
            EPI_FENCE(); }
    }
};
struct EpiPW {
    bf16_t* PW0; bf16_t* PW1;
    struct Pre {}; __device__ __forceinline__ void prefetch(Pre&, const pg8::Unit&, int, int, int, int) const {}
    __device__ __forceinline__ void operator()(const Acc& acc, const pg8::Unit& u, int wr, int wc, int fr, int fq, const Pre&) const {
        const int row0 = u.pm * 256 + wr * 64 + fr, col0 = u.pn * 256 + wc * 32 + 8 * fq;
        bf16_t* PW = u.pm < PW_SPLIT_PM ? PW0 : PW1;
#pragma unroll
        for (int ai = 0; ai < 2; ++ai)
#pragma unroll
            for (int m = 0; m < 4; ++m) { const int row = row0 + ai * 128 + m * 16;
#pragma unroll
                for (int bj = 0; bj < 2; ++bj) *(u32x4*)(PW + (size_t)row * DM + col0 + bj * 128) = pack8(acc[ai][bj][m][0], acc[ai][bj][m][1]); }
    }
};
template <bool FINAL> struct EpiGateB {
    const float* SS; const float* bg; const bf16_t* PW0; const bf16_t* PW1; const bf16_t* hres; float* out; bf16_t* HBo; float* SSo;
    struct Pre {}; __device__ __forceinline__ void prefetch(Pre&, const pg8::Unit&, int, int, int, int) const {}
    __device__ __forceinline__ void operator()(const Acc& acc, const pg8::Unit& u, int wr, int wc, int fr, int fq, const Pre&) const {
        asm volatile("" : "+v"(fr), "+v"(fq));
        const int row0 = u.pm * 256 + wr * 64 + fr, col0 = u.pn * 256 + wc * 32 + 8 * fq;
        const bf16_t* PW = u.pm < PW_SPLIT_PM ? PW0 : PW1;
#pragma unroll
        for (int ai = 0; ai < 2; ++ai)
#pragma unroll
            for (int mp = 0; mp < 2; ++mp) {
                f32x4 s4[2]; u32x4 pw[2][2], hr[2][2];
#pragma unroll
                for (int mm = 0; mm < 2; ++mm) { const int row = row0 + ai * 128 + (2 * mp + mm) * 16; s4[mm] = *(const f32x4*)(SS + (size_t)row * 16 + 4 * fq);
#pragma unroll
                    for (int bj = 0; bj < 2; ++bj) { const size_t off = (size_t)row * DM + col0 + bj * 128; hr[mm][bj] = *(const u32x4*)(hres + off); pw[mm][bj] = *(const u32x4*)(PW + off); } }
#pragma unroll
                for (int mm = 0; mm < 2; ++mm) { const int m = 2 * mp + mm, row = row0 + ai * 128 + m * 16; float sq = 0.f;
                    const float rs = rsqrtf(red_fq((s4[mm][0] + s4[mm][1]) + (s4[mm][2] + s4[mm][3])) * (1.f / 1024.f) + EPS);
#pragma unroll
                    for (int bj = 0; bj < 2; ++bj) { const size_t off = (size_t)row * DM + col0 + bj * 128;
                        f32x4 p0, p1, o0, o1; bf8_unpack(pw[mm][bj], p0, p1); bf8_unpack(hr[mm][bj], o0, o1);
                        const f32x4 b0 = *(const f32x4*)(bg + col0 + bj * 128), b1 = *(const f32x4*)(bg + col0 + bj * 128 + 4);
                        const f32x4 g0 = sig4(acc[ai][bj][m][0] * rs + b0), g1 = sig4(acc[ai][bj][m][1] * rs + b1);
                        const f32x4 x0 = o0 + g0 * p0, x1 = o1 + g1 * p1;
                        if (FINAL) { *(f32x4*)(out + off) = x0; *(f32x4*)(out + off + 4) = x1; }
                        else { *(u32x4*)(HBo + off) = pack8(x0, x1); sq += dot4(x0) + dot4(x1); } }
                    if (!FINAL) { sq = red_fq(sq); if (fq == 0) SSo[(size_t)row * 16 + u.pn * 4 + wc] = sq; } }
                EPI_FENCE(); }
    }
};
__device__ __forceinline__ void head_rope(f32x4 (&v)[2][2], const f32x4 c, const f32x4 s, int fq) {
    if (fq < 2) { const f32x4 x1 = v[0][0], x2 = v[0][1]; v[0][0] = x1 * c - x2 * s; v[0][1] = x2 * c + x1 * s; }
}
__device__ __forceinline__ float head_rs(const f32x4 (&v)[2][2]) { return rsqrtf(red_fq((dot4(v[0][0]) + dot4(v[0][1])) + (dot4(v[1][0]) + dot4(v[1][1]))) * (1.f / 64.f) + EPS); }
__device__ __forceinline__ int head_dq(int bj, int n, int fq) { return bj ? 32 + 8 * fq + 4 * n : (fq < 2 ? 8 * n + 4 * fq : 8 * fq + 4 * n); }
__device__ __forceinline__ void rope_quad(const int pos, const int fodd, f32x4& c, f32x4& s) {
    const float k0[4] = {1.0f, 0.193922758102417f, 0.03760603442788124f, 0.007292665541172028f}, k1[4] = {0.0014142137952148914f, 0.00027424830477684736f, 5.3182971896603703e-05f, 1.031338433676865e-05f};
#pragma unroll
    for (int e = 0; e < 4; ++e) { const float ang = (float)pos * (fodd ? k1[e] : k0[e]); const double rev = (double)ang * 0.15915494309189535; const float fr = (float)(rev - rint(rev));
        c[e] = __builtin_amdgcn_cosf(fr); s[e] = __builtin_amdgcn_sinf(fr); }
}
__device__ __forceinline__ void head_store16(bf16_t* rowp, const f32x4 (&v)[2][2], int fq) {
    const u32x2 p00 = pack4(v[0][0]), p01 = pack4(v[0][1]);
    const u32x2 snd = fq == 0 ? p01 : p00;
    u32x2 rcv; rcv.x = (unsigned)__builtin_amdgcn_ds_swizzle((int)snd.x, 0x401F); rcv.y = (unsigned)__builtin_amdgcn_ds_swizzle((int)snd.y, 0x401F);
    u32x4 w0;
    if (fq == 0) { w0.x = p00.x; w0.y = p00.y; w0.z = rcv.x; w0.w = rcv.y; }
    else if (fq == 1) { w0.x = rcv.x; w0.y = rcv.y; w0.z = p01.x; w0.w = p01.y; }
    else { w0.x = p00.x; w0.y = p00.y; w0.z = p01.x; w0.w = p01.y; }
    *(u32x4*)(rowp + 8 * fq) = w0;
    *(u32x4*)(rowp + 32 + 8 * fq) = pack8(v[1][0], v[1][1]);
}
__device__ __forceinline__ void rope4_load(const float* ROPE, int rowbase, int fq, f32x4 (&c)[4], f32x4 (&s)[4]) {
    const int fo = 4 * (fq & 1);
#pragma unroll
    for (int m = 0; m < 4; ++m) { const float* rp = ROPE + (size_t)(rowbase + 16 * m) * 16 + fo; c[m] = *(const f32x4*)rp; s[m] = *(const f32x4*)(rp + 8); }
}

struct EpiProj {
    Bufs B; const float* SS; const float* g_kn; const float* g_ik; const float* i_bias; const float* f_bias;
    struct Pre {}; __device__ __forceinline__ void prefetch(Pre&, const pg8::Unit&, int, int, int, int) const {}
    __device__ __forceinline__ void operator()(const Acc& acc, const pg8::Unit& u, int wr, int wc, int fr, int fq, const Pre&) const {
        asm volatile("" : "+v"(fr), "+v"(fq));
        const int pn = u.pn, row0 = u.pm * 256 + wr * 64 + fr, colw = wc * 32 + 8 * fq;
        if (pn == 0 || (pn >= 2 && pn <= 9)) {
            bf16_t* dst; int ld, cb;
            if (pn == 0) { dst = B.CQ; ld = 256; cb = 0; } else if (pn < 4) { dst = B.MQ; ld = 512; cb = (pn - 2) * 256; } else if (pn < 6) { dst = B.MK; ld = 512; cb = (pn - 4) * 256; }
            else if (pn < 8) { dst = B.MV; ld = 512; cb = (pn - 6) * 256; } else { dst = B.MO; ld = 512; cb = (pn - 8) * 256; }
            float rs8[8];
            { f32x4 s4[8];
#pragma unroll
              for (int i = 0; i < 8; ++i) s4[i] = *(const f32x4*)(SS + (size_t)(row0 + (i >> 2) * 128 + (i & 3) * 16) * 16 + 4 * fq);
#pragma unroll
              for (int i = 0; i < 8; ++i) rs8[i] = rsqrtf(red_fq((s4[i][0] + s4[i][1]) + (s4[i][2] + s4[i][3])) * (1.f / 1024.f) + EPS); }
#pragma unroll
            for (int ai = 0; ai < 2; ++ai) {
                float rs[4];
#pragma unroll
                for (int m = 0; m < 4; ++m) rs[m] = rs8[ai * 4 + m];
#pragma unroll
                for (int m = 0; m < 4; ++m) { const int row = row0 + ai * 128 + m * 16; float sq = 0.f;
#pragma unroll
                    for (int bj = 0; bj < 2; ++bj) { f32x4 a = acc[ai][bj][m][0] * rs[m], b = acc[ai][bj][m][1] * rs[m];
                        if (pn >= 8) { a = sig4(a); b = sig4(b); }
                        sq += dot4(a) + dot4(b);
                        *(u32x4*)(dst + (size_t)row * ld + cb + bj * 128 + colw) = pack8(a, b); }
                    if (pn == 0) { sq = red_fq(sq); if (fq == 0) B.CQSS[(size_t)row * 4 + wc] = sq; } }
                EPI_FENCE(); }
        } else if (pn == 1) {
            int dq[2][2];
#pragma unroll
            for (int bj = 0; bj < 2; ++bj)
#pragma unroll
                for (int n = 0; n < 2; ++n) dq[bj][n] = head_dq(bj, n, fq);
#pragma unroll
            for (int ai = 0; ai < 2; ++ai) {
#pragma unroll
                for (int mp = 0; mp < 2; ++mp) {
                    float rs2[2]; rs2_load(SS, row0 + ai * 128 + 32 * mp, fq, rs2);
                    f32x4 rc[2], rsn[2]; const int fo = 4 * (fq & 1);
                    if (wc < 2) {
#pragma unroll
                        for (int mm = 0; mm < 2; ++mm) { const float* rp = B.ROPE + (size_t)(row0 + ai * 128 + (2 * mp + mm) * 16) * 16 + fo; rc[mm] = *(const f32x4*)rp; rsn[mm] = *(const f32x4*)(rp + 8); } }
#pragma unroll
                    for (int mm = 0; mm < 2; ++mm) { const int m = 2 * mp + mm, row = row0 + ai * 128 + m * 16;
                        f32x4 v[2][2];
#pragma unroll
                        for (int bj = 0; bj < 2; ++bj)
#pragma unroll
                            for (int n = 0; n < 2; ++n) v[bj][n] = acc[ai][bj][m][n] * rs2[mm];
                        if (wc < 2) {
                            const float hr = head_rs(v);
#pragma unroll
                            for (int bj = 0; bj < 2; ++bj)
#pragma unroll
                                for (int n = 0; n < 2; ++n) v[bj][n] = v[bj][n] * hr * *(const f32x4*)(g_kn + dq[bj][n]);
                            head_rope(v, rc[mm], rsn[mm], fq);
                            head_store16(B.K + (size_t)row * 128 + wc * 64, v, fq);
                        } else {
                            const int tk = row & (SEQ - 1), tkp = (tk & ~12) | ((tk & 4) << 1) | ((tk & 8) >> 1);
                            const unsigned vo = (unsigned)(((row >> 11) * 2 + (wc - 2)) * 64 * SEQ + tkp);
#pragma unroll
                            for (int bj = 0; bj < 2; ++bj)
#pragma unroll
                                for (int n = 0; n < 2; ++n)
#pragma unroll
                                    for (int j = 0; j < 4; ++j) B.VT[vo + (unsigned)((dq[bj][n] + j) * SEQ)] = f2bf(v[bj][n][j]);
                        } }
                    EPI_FENCE(); } }
        } else {
            if (wc == 0) {
                int dq[2][2];
#pragma unroll
                for (int bj = 0; bj < 2; ++bj)
#pragma unroll
                    for (int n = 0; n < 2; ++n) dq[bj][n] = head_dq(bj, n, fq);
#pragma unroll
                for (int ai = 0; ai < 2; ++ai) {
#pragma unroll
                    for (int mp = 0; mp < 2; ++mp) {
                        float rs2[2]; rs2_load(SS, row0 + ai * 128 + 32 * mp, fq, rs2);
                        f32x4 rc[2], rsn[2]; const int fo = 4 * (fq & 1);
#pragma unroll
                        for (int mm = 0; mm < 2; ++mm) { const float* rp = B.ROPE + (size_t)(row0 + ai * 128 + (2 * mp + mm) * 16) * 16 + fo; rc[mm] = *(const f32x4*)rp; rsn[mm] = *(const f32x4*)(rp + 8); }
#pragma unroll
                        for (int mm = 0; mm < 2; ++mm) { const int m = 2 * mp + mm, row = row0 + ai * 128 + m * 16;
                            f32x4 v[2][2];
#pragma unroll
                            for (int bj = 0; bj < 2; ++bj)
#pragma unroll
                                for (int n = 0; n < 2; ++n) v[bj][n] = acc[ai][bj][m][n] * rs2[mm];
                            const float hr = head_rs(v);
#pragma unroll
                            for (int bj = 0; bj < 2; ++bj)
#pragma unroll
                                for (int n = 0; n < 2; ++n) v[bj][n] = v[bj][n] * hr * *(const f32x4*)(g_ik + dq[bj][n]);
                            head_rope(v, rc[mm], rsn[mm], fq);
                            head_store16(B.IK + (size_t)row * 64, v, fq); }
                        EPI_FENCE(); } }
            } else if (wc == 1) {
                const f32x4 ib = *(const f32x4*)i_bias, fb = *(const f32x4*)f_bias;
#pragma unroll
                for (int ai = 0; ai < 2; ++ai) {
                    float rs[4]; rs4_load(SS, row0 + ai * 128, fq, rs);
#pragma unroll
                    for (int m = 0; m < 4; ++m) { const int row = row0 + ai * 128 + m * 16;
                        const f32x4 a = acc[ai][0][m][0] * rs[m], b = acc[ai][0][m][1] * rs[m];
                        if (fq == 0) { *(f32x4*)(B.IW + (size_t)row * 8) = a * IDX_SCALE; *(f32x4*)(B.IW + (size_t)row * 8 + 4) = b * IDX_SCALE; }
                        else if (fq == 1) { *(f32x4*)(B.MI + (size_t)row * 4) = a + ib; f32x4 t = b + fb, o;
#pragma unroll
                            for (int j = 0; j < 4; ++j) o[j] = logsigmoidf_(t[j]);
                            *(f32x4*)(B.MF + (size_t)row * 4) = o; } }
                    EPI_FENCE(); }
            }
        }
    }
};
struct EpiQup {
    Bufs B; const float* g_qn; const int* pos;
    struct Pre {}; __device__ __forceinline__ void prefetch(Pre&, const pg8::Unit&, int, int, int, int) const {}
    __device__ __forceinline__ void operator()(const Acc& acc, const pg8::Unit& u, int wr, int wc, int fr, int fq, const Pre&) const {
        asm volatile("" : "+v"(fr), "+v"(fq));
        const int pn = u.pn, row0 = u.pm * 256 + wr * 64 + fr;
        int dq[2][2];
#pragma unroll
        for (int bj = 0; bj < 2; ++bj)
#pragma unroll
            for (int n = 0; n < 2; ++n) dq[bj][n] = head_dq(bj, n, fq);
        bf16_t* dst = (pn < 2 ? B.Q : B.IQ) + ((pn & 1) * 4 + wc) * 64;
        int pr[8]; float cp[8];
#pragma unroll
        for (int i = 0; i < 8; ++i) { const int row = row0 + (i >> 2) * 128 + (i & 3) * 16; pr[i] = pos[row]; cp[i] = B.CQSS[(size_t)row * 4 + fq]; }
        f32x4 gq[2][2];
#pragma unroll
        for (int bj = 0; bj < 2; ++bj)
#pragma unroll
            for (int n = 0; n < 2; ++n) gq[bj][n] = pn < 2 ? *(const f32x4*)(g_qn + dq[bj][n]) : (f32x4){1.f, 1.f, 1.f, 1.f};
#pragma unroll
        for (int ai = 0; ai < 2; ++ai)
#pragma unroll
            for (int m = 0; m < 4; ++m) { const int i = ai * 4 + m, row = row0 + ai * 128 + m * 16;
                const float rs = rsqrtf(red_fq(cp[i]) * (1.f / 256.f) + EPS);
                f32x4 rc, rsn; rope_quad(pr[i], fq & 1, rc, rsn);
                f32x4 v[2][2];
#pragma unroll
                for (int bj = 0; bj < 2; ++bj)
#pragma unroll
                    for (int n = 0; n < 2; ++n) v[bj][n] = acc[ai][bj][m][n] * rs;
                if (pn < 2) { const float hr = head_rs(v) * QSCALE;
#pragma unroll
                    for (int bj = 0; bj < 2; ++bj)
#pragma unroll
                        for (int n = 0; n < 2; ++n) v[bj][n] = v[bj][n] * hr * gq[bj][n]; }
                head_rope(v, rc, rsn, fq);
                head_store16(dst + (size_t)row * 512, v, fq); }
    }
};

__device__ __forceinline__ int proj_src_col(int n) {
    const int tile = n >> 8, p = n & 255, wc = (p >> 5) & 3, bj = p >> 7, q = p & 31, d = dimmap(bj * 32 + q);
    switch (tile) {
        case 0: return C_CQ + p;
        case 1: return wc < 2 ? C_AK + wc * 64 + d : C_AV + (wc - 2) * 64 + d;
        case 2: case 3: return C_MQ + (tile - 2) * 256 + p;
        case 4: case 5: return C_MK + (tile - 4) * 256 + p;
        case 6: case 7: return C_MV + (tile - 6) * 256 + p;
        case 8: case 9: return C_MO + (tile - 8) * 256 + p;
        default:
            if (wc == 0) return C_IK + d;
            if (wc == 1 && bj == 0) { if (q < 8) return C_IW + q; if (q < 12) return C_MI + q - 8; if (q < 16) return C_MF + q - 12; }
            return -1;
    }
}
__device__ __forceinline__ void prep_item(const float* W, int ldw, int c4, const float* g, bf16_t* Bt, int K, int n0, int k0, LAS float* scr, int lane) {
    f32x4 v[8];
#pragma unroll
    for (int i = 0; i < 8; ++i) { const int kk = 8 * i + (lane >> 3); v[i] = c4 >= 0 ? *(const f32x4*)(W + (size_t)(k0 + kk) * ldw + c4) : (f32x4){0.f, 0.f, 0.f, 0.f}; }
#pragma unroll
    for (int i = 0; i < 8; ++i) { const int kk = 8 * i + (lane >> 3); const float gs = g ? g[k0 + kk] : 1.f; LAS float* d = scr + kk * 33 + 4 * (lane & 7);
        d[0] = v[i][0] * gs; d[1] = v[i][1] * gs; d[2] = v[i][2] * gs; d[3] = v[i][3] * gs; }
    asm volatile("s_waitcnt lgkmcnt(0)" ::: "memory");
    const int cc = lane & 7;
#pragma unroll
    for (int j = 0; j < 4; ++j) { const int n = (lane >> 3) + 8 * j; const LAS float* s = scr + (8 * cc) * 33 + n;
        u32x4 o; o.x = cvt_pk_bf16(s[0 * 33], s[1 * 33]); o.y = cvt_pk_bf16(s[2 * 33], s[3 * 33]); o.z = cvt_pk_bf16(s[4 * 33], s[5 * 33]); o.w = cvt_pk_bf16(s[6 * 33], s[7 * 33]);
        *(u32x4*)(Bt + (size_t)(n0 + n) * K + k0 + 8 * cc) = o; }
    asm volatile("s_waitcnt lgkmcnt(0)" ::: "memory");
}

struct Args {
    const float* in[24]; float* out; unsigned char* ws; int ph_lo, ph_hi, bar_slot, pad;
};

__device__ __forceinline__ void phase_prologue(const Args& a, const Bufs& B, LAS unsigned char* lds, int gw, int NGW, int wave, int lane) {
    LAS float* scr = (LAS float*)(lds + wave * 8704);
    constexpr int I_IN = (DM / 64) * (NPROJ / 32), I_QUP = (QR / 64) * (1024 / 32), I_OUT = (DM / 64) * (DM / 32), I_F1 = (DM / 64) * (DFF / 32), I_F2 = (DFF / 64) * (DM / 32), I_G = I_OUT, I_P = (PLE / 64) * (DM / 32);
    constexpr int I_LAYER = I_IN + I_QUP + I_OUT + I_F1 + I_F2 + I_G + I_P;
    for (int it = gw; it < DEPTH * I_LAYER; it += NGW) {
        const int l = it / I_LAYER; int r = it % I_LAYER;
        unsigned char* wb = a.ws + WS_W + (size_t)l * W_LSTRIDE;
        const int lane31 = 4 * (lane & 7);
        if (r < I_IN) { const int nblk = NPROJ / 32, kb = r / nblk, nb = r % nblk; prep_item(a.in[4] + (size_t)l * DM * IN_W, IN_W, proj_src_col(nb * 32 + lane31), a.in[3] + l * DM, (bf16_t*)(wb + WO_IN), DM, nb * 32, kb * 64, scr, lane); continue; } r -= I_IN;
        if (r < I_QUP) { const int nblk = 32, kb = r / nblk, nb = r % nblk; const int n = nb * 32 + lane31, tile = n >> 8, p = n & 255, wc = (p >> 5) & 3, d = dimmap((p >> 7) * 32 + (p & 31));
            const float* W = (tile < 2 ? a.in[6] : a.in[7]) + (size_t)l * QR * 512;
            prep_item(W, 512, ((tile & 1) * 4 + wc) * 64 + d, a.in[5] + l * QR, (bf16_t*)(wb + WO_QUP), QR, nb * 32, kb * 64, scr, lane); continue; } r -= I_QUP;
        if (r < I_OUT) { const int nblk = DM / 32, kb = r / nblk, nb = r % nblk; prep_item(a.in[16] + (size_t)l * DM * DM, DM, nb * 32 + lane31, nullptr, (bf16_t*)(wb + WO_OUT), DM, nb * 32, kb * 64, scr, lane); continue; } r -= I_OUT;
        if (r < I_F1) { const int nblk = DFF / 32, kb = r / nblk, nb = r % nblk; prep_item(a.in[18] + (size_t)l * DM * DFF, DFF, nb * 32 + lane31, a.in[17] + l * DM, (bf16_t*)(wb + WO_F1), DM, nb * 32, kb * 64, scr, lane); continue; } r -= I_F1;
        if (r < I_F2) { const int nblk = DM / 32, kb = r / nblk, nb = r % nblk; prep_item(a.in[19] + (size_t)l * DFF * DM, DM, nb * 32 + lane31, nullptr, (bf16_t*)(wb + WO_F2), DFF, nb * 32, kb * 64, scr, lane); continue; } r -= I_F2;
        if (r < I_G) { const int nblk = DM / 32, kb = r / nblk, nb = r % nblk; prep_item(a.in[21] + (size_t)l * DM * DM, DM, nb * 32 + lane31, a.in[20] + l * DM, (bf16_t*)(wb + WO_G), DM, nb * 32, kb * 64, scr, lane); continue; } r -= I_G;
        { const int nblk = DM / 32, kb = r / nblk, nb = r % nblk; prep_item(a.in[23] + (size_t)l * PLE * DM, DM, nb * 32 + lane31, nullptr, (bf16_t*)(wb + WO_P), PLE, nb * 32, kb * 64, scr, lane); }
    }
    const float* x = a.in[0];
    for (int row0 = gw * 4; row0 < M; row0 += NGW * 4) {
        f32x4 v[4][4];
#pragma unroll
        for (int r = 0; r < 4; ++r) { const f32x4* xr = (const f32x4*)(x + (size_t)(row0 + r) * DM) + lane;
#pragma unroll
            for (int j = 0; j < 4; ++j) v[r][j] = xr[64 * j]; }
#pragma unroll
        for (int r = 0; r < 4; ++r) { float s = 0.f; u32x2* o = (u32x2*)((bf16_t*)a.out + (size_t)(row0 + r) * DM) + lane;
#pragma unroll
            for (int j = 0; j < 4; ++j) { s += dot4(v[r][j]); o[64 * j] = pack4(v[r][j]); }
            s = wave_sum(s);
            if (lane < 16) B.SS[(size_t)(row0 + r) * 16 + lane] = lane == 0 ? s : 0.f; }
    }
    const int* pos = (const int*)a.in[2];
    for (int i = gw * 64 + lane; i < M * 8; i += NGW * 64) {
        const int row = i >> 3, f = i & 7;
        const float inv = exp2f(-(float)f * (18.931568569324174f / 8.f));
        const float ang = (float)pos[row] * inv;
        const double rev = (double)ang * 0.15915494309189535; const float fr = (float)(rev - rint(rev));
        B.ROPE[row * 16 + f] = __builtin_amdgcn_cosf(fr); B.ROPE[row * 16 + 8 + f] = __builtin_amdgcn_sinf(fr);
    }
    const f32x4* p4 = (const f32x4*)a.in[1]; u32x2* pb = (u32x2*)B.PB;
#pragma unroll 4
    for (size_t i = (size_t)gw * 64 + lane; i < (size_t)DEPTH * M * PLE / 4; i += (size_t)NGW * 64) pb[i] = pack4(p4[i]);
}

typedef float f32x16 __attribute__((ext_vector_type(16)));
__device__ __forceinline__ unsigned half_sum_u(unsigned v) {
#pragma unroll
    for (int o = 1; o < 32; o <<= 1) v += (unsigned)__shfl_xor((int)v, o);
    return v;
}
__device__ __forceinline__ unsigned half_sum_dpp(unsigned v, int hf) {
    v += (unsigned)__builtin_amdgcn_update_dpp(0, (int)v, 0xB1, 0xf, 0xf, false);
    v += (unsigned)__builtin_amdgcn_update_dpp(0, (int)v, 0x4E, 0xf, 0xf, false);
    v += (unsigned)__builtin_amdgcn_update_dpp(0, (int)v, 0x141, 0xf, 0xf, false);
    v += (unsigned)__builtin_amdgcn_update_dpp(0, (int)v, 0x140, 0xf, 0xf, false);
    const unsigned s0 = (unsigned)__builtin_amdgcn_readlane((int)v, 0), s1 = (unsigned)__builtin_amdgcn_readlane((int)v, 16), s2 = (unsigned)__builtin_amdgcn_readlane((int)v, 32), s3 = (unsigned)__builtin_amdgcn_readlane((int)v, 48);
    return hf ? s2 + s3 : s0 + s1;
}
struct IdxPre { bf16x8 af0, af1; f32x4 w; u32x4 g0[4]; };
__device__ __forceinline__ void idx_preload(IdxPre& P, const Bufs& B, int b, int qb, int wave, int lane) {
    const int hf = lane >> 5, l15 = lane & 15, q4 = lane >> 4, tid = wave * 64 + lane;
    const int q0w = qb * 16 + 2 * wave, q = q0w + hf; const size_t rowb = (size_t)b * SEQ;
    const bf16_t* aqb = B.IQ + rowb * 512; const unsigned ao = (unsigned)((q0w + (l15 >> 3)) * 512 + (l15 & 7) * 64 + 8 * q4);
    P.af0 = *(const bf16x8*)(aqb + ao); P.af1 = *(const bf16x8*)(aqb + (ao + 32u));
    P.w = *(const f32x4*)(B.IW + rowb * 8 + (unsigned)q * 8u + 4u * (unsigned)(q4 & 1));
    const bf16_t* kb = B.IK + rowb * 64;
#pragma unroll
    for (int i = 0; i < 4; ++i) P.g0[i] = *(const u32x4*)(kb + ((unsigned)tid * 8u + (unsigned)i * 4096u));
}
__device__ __forceinline__ int idx_wg_item(const Bufs& B, LAS unsigned char* lds, int b, int qb, int wave, int lane, const IdxPre& P, IdxPre& Pn, volatile LAS int* slotn, bool ldr, int nxt, int dsh, int bb) {
    { unsigned m1 = ~0u; asm volatile("" : "+s"(m1)); lane = (int)__builtin_amdgcn_mbcnt_hi(m1, __builtin_amdgcn_mbcnt_lo(m1, 0u)); }
    const int hf = lane >> 5, l31 = lane & 31, l15 = lane & 15, q4 = lane >> 4, tid = wave * 64 + lane;
    const int q0w = qb * 16 + 2 * wave;
    const int nt = ((qb * 16 + 15) >> 5) + 1, ng = (nt + 7) >> 3;
    const size_t rowb = (size_t)b * SEQ;
    const int q = q0w + hf;
    const bf16x8 af0 = P.af0, af1 = P.af1;
    float w4[4];
#pragma unroll
    for (int j = 0; j < 4; ++j) w4[j] = P.w[j];
    const bf16_t* kb = B.IK + rowb * 64;
    const int sd0 = (tid >> 3) * 128 + (((tid & 7) ^ ((tid >> 3) & 7)) << 4);
    int roff[2][2];
#pragma unroll
    for (int th = 0; th < 2; ++th)
#pragma unroll
        for (int ks = 0; ks < 2; ++ks) roff[th][ks] = (16 * th + l15) * 128 + (((4 * ks + q4) ^ (l15 & 7)) << 4);
    unsigned sc[64];
    u32x4 pre[4], nx2[4];
    unsigned go = (unsigned)tid * 8u;
    asm volatile("" : "+v"(go));
#pragma unroll
    for (int i = 0; i < 4; ++i) pre[i] = P.g0[i];
    __syncthreads();
#pragma unroll
    for (int i = 0; i < 4; ++i) *(LAS u32x4*)(lds + sd0 + i * 8192) = pre[i];
    if (ng > 1) { go += 256u * 64u; asm volatile("" : "+v"(go));
#pragma unroll
        for (int i = 0; i < 4; ++i) pre[i] = *(const u32x4*)(kb + (go + (unsigned)i * 4096u)); }
    __syncthreads();
#pragma unroll
    for (int g = 0; g < 8; ++g) {
        if (g < ng) {
            if (g + 2 < ng) {
                go += 256u * 64u; asm volatile("" : "+v"(go));
#pragma unroll
                for (int i = 0; i < 4; ++i) nx2[i] = *(const u32x4*)(kb + (go + (unsigned)i * 4096u)); }
            const LAS unsigned char* buf = lds + (g % 3) * 32768;
            bf16x8 fr[4], fn[4];
            fr[0] = *(const LAS bf16x8*)(buf + roff[0][0]); fr[1] = *(const LAS bf16x8*)(buf + roff[1][0]); fr[2] = *(const LAS bf16x8*)(buf + roff[0][1]); fr[3] = *(const LAS bf16x8*)(buf + roff[1][1]);
            float own_p = 0.f, rcv_p = 0.f;
#pragma unroll
            for (int tt = 0; tt < 8; ++tt) { const int t = g * 8 + tt;
                if (tt < 7) { fn[0] = *(const LAS bf16x8*)(buf + (tt + 1) * 4096 + roff[0][0]); fn[1] = *(const LAS bf16x8*)(buf + (tt + 1) * 4096 + roff[1][0]);
                              fn[2] = *(const LAS bf16x8*)(buf + (tt + 1) * 4096 + roff[0][1]); fn[3] = *(const LAS bf16x8*)(buf + (tt + 1) * 4096 + roff[1][1]); }
                f32x4 a0 = {0.f, 0.f, 0.f, 0.f}, a1 = {0.f, 0.f, 0.f, 0.f};
                a0 = __builtin_amdgcn_mfma_f32_16x16x32_bf16(af0, fr[0], a0, 0, 0, 0);
                a1 = __builtin_amdgcn_mfma_f32_16x16x32_bf16(af0, fr[1], a1, 0, 0, 0);
                a0 = __builtin_amdgcn_mfma_f32_16x16x32_bf16(af1, fr[2], a0, 0, 0, 0);
                a1 = __builtin_amdgcn_mfma_f32_16x16x32_bf16(af1, fr[3], a1, 0, 0, 0);
                if (tt > 0) { const float s = own_p + rcv_p; const unsigned vm = (unsigned)-(int)(((t - 1) * 32 + l31) <= q); sc[t - 1] = f2ord(s + 0.f) & vm; }
                float p0 = 0.f, p1 = 0.f;
#pragma unroll
                for (int r = 0; r < 4; ++r) { p0 += w4[r] * __int_as_float(max(__float_as_int(a0[r]), 0)); p1 += w4[r] * __int_as_float(max(__float_as_int(a1[r]), 0)); }
                const float snd = (q4 & 1) ? p0 : p1;
                rcv_p = __int_as_float(__builtin_amdgcn_ds_swizzle(__float_as_int(snd), 0x401F));
                own_p = (q4 & 1) ? p1 : p0;
#pragma unroll
                for (int i = 0; i < 4; ++i) fr[i] = fn[i];
            }
            { const int t = g * 8 + 7; const float s = own_p + rcv_p; const unsigned vm = (unsigned)-(int)((t * 32 + l31) <= q); sc[t] = f2ord(s + 0.f) & vm; }
            if (g + 1 < ng) {
#pragma unroll
                for (int i = 0; i < 4; ++i) *(LAS u32x4*)(lds + ((g + 1) % 3) * 32768 + sd0 + i * 8192) = pre[i]; }
#pragma unroll
            for (int i = 0; i < 4; ++i) pre[i] = nx2[i];
            __syncthreads();
        } else {
#pragma unroll
            for (int tt = 0; tt < 8; ++tt) sc[g * 8 + tt] = 0u;
        }
    }
    int itn;
    { if (ldr) slotn[0] = nxt; __syncthreads(); itn = __builtin_amdgcn_readfirstlane(slotn[0]); if (itn < (128 << dsh)) idx_preload(Pn, B, bb + (itn & ((1 << dsh) - 1)), 127 - (itn >> dsh), wave, lane); }
    const bool need = q + 1 > TOPK;
    unsigned Pth = 0u, r_take = 0u;
    if (__any(need)) {
        unsigned prefix = 0u, cge = 0xffffffffu, nhi = 0u; bool done = !need; int bit = 31;
#pragma unroll 1
        for (; bit >= 0; --bit) {
            if (!__any(!done && (cge - nhi > 32u))) break;
            const unsigned cand = prefix | (1u << bit);
            unsigned c0 = 0u, c1 = 0u;
#pragma unroll
            for (int t8 = 0; t8 < 8; ++t8) if (t8 < ng) {
#pragma unroll
                for (int tt = 0; tt < 8; tt += 2) { c0 += sc[t8 * 8 + tt] >= cand ? 1u : 0u; c1 += sc[t8 * 8 + tt + 1] >= cand ? 1u : 0u; } }
            const unsigned c = half_sum_dpp(c0 + c1, hf);
            if (!done) { if (c >= (unsigned)TOPK) { prefix = cand; cge = c; } else nhi = c; if (c == (unsigned)TOPK) { done = true; Pth = cand - 1u; } }
        }
        if (__any(!done)) {
            int hfl = hf; asm volatile("" : "+v"(hfl));
            LAS unsigned* lst = (LAS unsigned*)(lds + 98304) + (wave * 2 + hfl) * 32;
            const int sh = bit + 1;
            unsigned base = 0u;
#pragma unroll
            for (int t8 = 0; t8 < 8; ++t8) if (t8 < ng) {
#pragma unroll
                for (int tt = 0; tt < 8; ++tt) { const unsigned v = sc[t8 * 8 + tt];
                    const bool fl = !done && v != 0u && ((v ^ prefix) >> sh) == 0u;
                    const unsigned long long bm = __ballot(fl); const unsigned mh = hf ? (unsigned)(bm >> 32) : (unsigned)bm;
                    const unsigned pos = base + __popc(mh & ((1u << l31) - 1u));
                    if (fl && pos < 32u) lst[pos] = v;
                    base += __popc(mh); } }
            const unsigned cv = (unsigned)l31 < base ? lst[l31] : 0u;
#pragma unroll 1
            for (; bit >= 0; --bit) {
                if (__all(done)) break;
                const unsigned cand = prefix | (1u << bit);
                const unsigned long long bm = __ballot(cv >= cand); const unsigned c = nhi + __popc(hf ? (unsigned)(bm >> 32) : (unsigned)bm);
                if (!done) { if (c >= (unsigned)TOPK) prefix = cand; if (c == (unsigned)TOPK) { done = true; Pth = cand - 1u; } }
            }
            const bool tie = need && !done;
            if (__any(tie)) {
                const unsigned long long bm = __ballot(cv > prefix); const unsigned c = nhi + __popc(hf ? (unsigned)(bm >> 32) : (unsigned)bm);
                if (tie) { Pth = prefix; r_take = (unsigned)TOPK - c; }
            }
        }
    }
    const bool anytie = __any(r_take > 0u);
    unsigned taken = 0u;
    unsigned* sob = B.SEL + rowb * 64; const unsigned soo = (unsigned)q * 64u;
    int hfw = hf; asm volatile("" : "+v"(hfw));
    LAS unsigned* wl = (LAS unsigned*)(lds + 98304 + 2048) + (wave * 2 + hfw) * 64;
#pragma unroll
    for (int t = 0; t < 64; ++t) {
        unsigned wsel = 0u;
        if ((t >> 3) < ng) {
            const unsigned v = sc[t];
            bool sel = v > Pth;
            if (anytie) {
                const bool eq = (v == Pth) && (r_take > 0u);
                const unsigned long long bm = __ballot(eq); const unsigned mh = hf ? (unsigned)(bm >> 32) : (unsigned)bm;
                const unsigned below = __popc(mh & ((1u << l31) - 1u));
                sel = sel || (eq && (taken + below < r_take));
                taken += __popc(mh);
            }
            const unsigned long long sm = __ballot(sel);
            wsel = hf ? (unsigned)(sm >> 32) : (unsigned)sm;
        }
        if (l31 == 0) wl[t] = wsel;
    }
    sob[soo + (unsigned)l31] = wl[l31]; sob[soo + 32u + (unsigned)l31] = wl[32 + l31];
    return itn;
}
constexpr int AT_KB = 0, AT_VB = 49152, AT_SEL = 98304, AT_END = 114688;
__device__ __forceinline__ unsigned cvt_pk_bf16_nv(float lo, float hi) { unsigned r; asm("v_cvt_pk_bf16_f32 %0, %1, %2" : "=v"(r) : "v"(lo), "v"(hi)); return r; }
template <int G, bool HAS_QK, bool HAS_PV>
__device__ __forceinline__ void att_group(f32x16& Sc, const unsigned mw, float& ps, unsigned (&w)[8], f32x16& Sn, const bf16x8 (&kfn)[4], const bf16x8 (&qfn)[4],
                                          f32x16 (&oa)[2], const bf16x8 (&vf)[2][2], const bf16x8 (&pbp)[2]) {
    if constexpr (HAS_QK && G < 4) {
        if constexpr (G == 0) { const f32x16 z = {0.f, 0.f, 0.f, 0.f, 0.f, 0.f, 0.f, 0.f, 0.f, 0.f, 0.f, 0.f, 0.f, 0.f, 0.f, 0.f}; Sn = __builtin_amdgcn_mfma_f32_32x32x16_bf16(kfn[0], qfn[0], z, 0, 0, 0); }
        else Sn = __builtin_amdgcn_mfma_f32_32x32x16_bf16(kfn[G], qfn[G], Sn, 0, 0, 0);
        asm volatile("" : "+v"(Sn));
    }
    if constexpr (HAS_PV && G >= 4) { oa[(G - 4) >> 1] = __builtin_amdgcn_mfma_f32_32x32x16_bf16(vf[(G - 4) >> 1][(G - 4) & 1], pbp[(G - 4) & 1], oa[(G - 4) >> 1], 0, 0, 0);
        asm volatile("" : "+v"(oa[(G - 4) >> 1])); }
    constexpr int R = 2 * G;
    asm volatile("" : "+v"(Sc));
    float x0 = Sc[R], x1 = Sc[R + 1];
    const float e0 = __builtin_amdgcn_exp2f(x0), e1 = __builtin_amdgcn_exp2f(x1); int m0, m1;
    asm("v_bfe_i32 %0, %1, %2, 1" : "=v"(m0) : "v"(mw), "n"((R & 3) + 8 * (R >> 2)));
    asm("v_bfe_i32 %0, %1, %2, 1" : "=v"(m1) : "v"(mw), "n"(((R + 1) & 3) + 8 * ((R + 1) >> 2)));
    const float p0 = __int_as_float(__float_as_int(e0) & m0), p1 = __int_as_float(__float_as_int(e1) & m1);
    ps += p0 + p1; asm volatile("" : "+v"(ps));
    w[G] = cvt_pk_bf16_nv(p0, p1);
    __builtin_amdgcn_sched_barrier(0);
}
template <bool HAS_QK, bool HAS_PV>
__device__ __forceinline__ void att_step(f32x16& Sc, const unsigned mw, float& lsum, bf16x8 (&pbo)[2], f32x16& Sn, const bf16x8 (&kfn)[4], const bf16x8 (&qfn)[4],
                                         f32x16 (&oa)[2], const bf16x8 (&vf)[2][2], const bf16x8 (&pbp)[2]) {
    unsigned w[8]; float ps = 0.f;
    __builtin_amdgcn_sched_barrier(0);
    att_group<0, HAS_QK, HAS_PV>(Sc, mw, ps, w, Sn, kfn, qfn, oa, vf, pbp); att_group<1, HAS_QK, HAS_PV>(Sc, mw, ps, w, Sn, kfn, qfn, oa, vf, pbp);
    att_group<2, HAS_QK, HAS_PV>(Sc, mw, ps, w, Sn, kfn, qfn, oa, vf, pbp); att_group<3, HAS_QK, HAS_PV>(Sc, mw, ps, w, Sn, kfn, qfn, oa, vf, pbp);
    att_group<4, HAS_QK, HAS_PV>(Sc, mw, ps, w, Sn, kfn, qfn, oa, vf, pbp); att_group<5, HAS_QK, HAS_PV>(Sc, mw, ps, w, Sn, kfn, qfn, oa, vf, pbp);
    att_group<6, HAS_QK, HAS_PV>(Sc, mw, ps, w, Sn, kfn, qfn, oa, vf, pbp); att_group<7, HAS_QK, HAS_PV>(Sc, mw, ps, w, Sn, kfn, qfn, oa, vf, pbp);
    lsum += ps;
    u32x4 x0, x1; x0.x = w[0]; x0.y = w[1]; x0.z = w[2]; x0.w = w[3]; x1.x = w[4]; x1.y = w[5]; x1.z = w[6]; x1.w = w[7];
    pbo[0] = __builtin_bit_cast(bf16x8, x0); pbo[1] = __builtin_bit_cast(bf16x8, x1);
}
__device__ __forceinline__ void att_wg_item(const Bufs& B, LAS unsigned char* lds, int b, int qb, int wave, int lane) {
    { unsigned m1 = ~0u; asm volatile("" : "+s"(m1)); lane = (int)__builtin_amdgcn_mbcnt_hi(m1, __builtin_amdgcn_mbcnt_lo(m1, 0u)); }
    const int hf = lane >> 5, l31 = lane & 31, tid = wave * 64 + lane, wv = __builtin_amdgcn_readfirstlane(wave);
    const int g = wave & 1, q0 = qb * 64, qa = q0 + 16 * (wave >> 1);
    const int ns = qb + 1;
    const size_t rowb = (size_t)b * SEQ;
    const bf16_t* kbase = B.K + rowb * 128; const bf16_t* vbase = B.VT + (size_t)b * 128 * SEQ;
    unsigned ksrc[2], vsrc[2];
#pragma unroll
    for (int i = 0; i < 2; ++i) { const int p = tid + 512 * i;
        { const int row = p >> 4, ss = p & 15; ksrc[i] = (unsigned)(row * 256 + ((ss ^ (row & 7)) << 4)); }
        { const int row = p >> 3, ss = p & 7; vsrc[i] = (unsigned)(row * (SEQ * 2) + ((ss ^ ((row >> 1) & 7)) << 4)); } }
#define ATT_DMA(slot_, ko_, vo_) do { _Pragma("unroll") for (int _i = 0; _i < 2; ++_i) { \
        __builtin_amdgcn_global_load_lds((const unsigned*)(((const char*)kbase + (ko_)) + ksrc[_i]), (LAS unsigned*)(lds + AT_KB + (slot_) * 16384 + _i * 8192 + wv * 1024), 16, 0, 0); \
        __builtin_amdgcn_global_load_lds((const unsigned*)(((const char*)vbase + (vo_)) + vsrc[_i]), (LAS unsigned*)(lds + AT_VB + (slot_) * 16384 + _i * 8192 + wv * 1024), 16, 0, 0); } } while (0)
    __syncthreads();
    ATT_DMA(0, 0u, 0u);
    if (ns > 1) ATT_DMA(1, 64u * 256u, 128u);
    { const unsigned* sb = B.SEL + (rowb + q0) * 64;
#pragma unroll
      for (int i = 0; i < 2; ++i) *(LAS u32x4*)(lds + AT_SEL + (tid + 512 * i) * 16) = *(const u32x4*)(sb + (tid + 512 * i) * 4); }
    bf16x8 qf[2][4];
    { const bf16_t* qbase = B.Q + rowb * 512;
#pragma unroll
      for (int c2 = 0; c2 < 2; ++c2) { const unsigned qo = (unsigned)((qa + 8 * c2 + (l31 >> 2)) * 512 + (4 * g + (l31 & 3)) * 64 + 8 * hf);
#pragma unroll
        for (int ks = 0; ks < 4; ++ks) qf[c2][ks] = *(const bf16x8*)(qbase + (qo + 16u * ks)); } }
    f32x16 o[2][2]; float lsum[2] = {0.f, 0.f};
#pragma unroll
    for (int c2 = 0; c2 < 2; ++c2)
#pragma unroll
        for (int dt = 0; dt < 2; ++dt)
#pragma unroll
            for (int r = 0; r < 16; ++r) o[c2][dt][r] = 0.f;
    unsigned koff = 64u * 256u, voff = 128u;
    if (ns > 1) asm volatile("s_waitcnt vmcnt(4)" ::: "memory"); else asm volatile("s_waitcnt vmcnt(0)" ::: "memory");
    __syncthreads();
    int kro[4];
#pragma unroll
    for (int ks = 0; ks < 4; ++ks) kro[ks] = l31 * 256 + (((g * 8 + 2 * ks + hf) ^ (l31 & 7)) << 4);
    const int selo = AT_SEL + ((16 * (wave >> 1) + (l31 >> 2)) * 64) * 4;
    int cur = 0;
#pragma unroll 1
    for (int st = 0; st < ns; ++st) {
        const int nx2 = cur == 0 ? 2 : cur - 1;
        if (st + 2 < ns) { koff += 64u * 256u; voff += 128u; asm volatile("" : "+s"(koff), "+s"(voff)); ATT_DMA(nx2, koff, voff); }
        const LAS unsigned char* kb = lds + AT_KB + cur * 16384; const LAS unsigned char* vb = lds + AT_VB + cur * 16384;
        {
            bf16x8 kf0[4], kf1[4], vfa[2][2], vfb[2][2], pbA[2], pbB[2]; f32x16 Sa, Sb;
#pragma unroll
            for (int ks = 0; ks < 4; ++ks) kf0[ks] = *(const LAS bf16x8*)(kb + kro[ks]);
            const LAS unsigned* swp = (const LAS unsigned*)(lds + selo + st * 8);
            const unsigned mw00 = swp[0] >> (4 * hf), mw10 = swp[1] >> (4 * hf), mw01 = swp[8 * 64] >> (4 * hf), mw11 = swp[8 * 64 + 1] >> (4 * hf);
            { const f32x16 z = {0.f, 0.f, 0.f, 0.f, 0.f, 0.f, 0.f, 0.f, 0.f, 0.f, 0.f, 0.f, 0.f, 0.f, 0.f, 0.f};
              Sa = __builtin_amdgcn_mfma_f32_32x32x16_bf16(kf0[0], qf[0][0], z, 0, 0, 0);
#pragma unroll
              for (int ks = 1; ks < 4; ++ks) Sa = __builtin_amdgcn_mfma_f32_32x32x16_bf16(kf0[ks], qf[0][ks], Sa, 0, 0, 0); }
#pragma unroll
            for (int ks = 0; ks < 4; ++ks) kf1[ks] = *(const LAS bf16x8*)(kb + 8192 + kro[ks]);
            att_step<true, false>(Sa, mw00, lsum[0], pbA, Sb, kf0, qf[1], o[0], vfa, pbA);
#pragma unroll
            for (int dt = 0; dt < 2; ++dt) { const int row = g * 64 + 32 * dt + l31; const LAS unsigned char* vr = vb + row * 128; const int sw = (row >> 1) & 7;
#pragma unroll
                for (int s = 0; s < 2; ++s) vfa[dt][s] = *(const LAS bf16x8*)(vr + (((2 * s + hf) ^ sw) << 4)); }
            att_step<true, true>(Sb, mw01, lsum[1], pbB, Sa, kf1, qf[0], o[0], vfa, pbA);
            att_step<true, true>(Sa, mw10, lsum[0], pbA, Sb, kf1, qf[1], o[1], vfa, pbB);
#pragma unroll
            for (int dt = 0; dt < 2; ++dt) { const int row = g * 64 + 32 * dt + l31; const LAS unsigned char* vr = vb + row * 128; const int sw = (row >> 1) & 7;
#pragma unroll
                for (int s = 0; s < 2; ++s) vfb[dt][s] = *(const LAS bf16x8*)(vr + (((4 + 2 * s + hf) ^ sw) << 4)); }
            att_step<false, true>(Sb, mw11, lsum[1], pbB, Sa, kf1, qf[1], o[0], vfb, pbA);
#pragma unroll
            for (int dt = 0; dt < 2; ++dt)
#pragma unroll
                for (int s = 0; s < 2; ++s) o[1][dt] = __builtin_amdgcn_mfma_f32_32x32x16_bf16(vfb[dt][s], pbB[s], o[1][dt], 0, 0, 0);
        }
        if (st + 2 < ns) asm volatile("s_waitcnt vmcnt(4)" ::: "memory"); else asm volatile("s_waitcnt vmcnt(0)" ::: "memory");
        asm volatile("s_waitcnt lgkmcnt(0)" ::: "memory");
        __builtin_amdgcn_s_barrier();
        cur = cur == 2 ? 0 : cur + 1;
    }
#undef ATT_DMA
    { unsigned m1 = ~0u; asm volatile("" : "+s"(m1)); const int ln = (int)__builtin_amdgcn_mbcnt_hi(m1, __builtin_amdgcn_mbcnt_lo(m1, 0u));
      bf16_t* ob = B.MIX + rowb * 1024;
#pragma unroll
      for (int c2 = 0; c2 < 2; ++c2) {
        const float l = lsum[c2] + __int_as_float(__builtin_amdgcn_ds_bpermute((ln ^ 32) << 2, __float_as_int(lsum[c2]))); const float inv = __builtin_amdgcn_rcpf(l);
        const unsigned oo = (unsigned)((qa + 8 * c2 + ((ln & 31) >> 2)) * 1024 + (4 * g + (ln & 3)) * 64 + 4 * (ln >> 5));
#pragma unroll
        for (int dt = 0; dt < 2; ++dt)
#pragma unroll
            for (int rr = 0; rr < 4; ++rr) { f32x4 v; v[0] = o[c2][dt][4 * rr] * inv; v[1] = o[c2][dt][4 * rr + 1] * inv; v[2] = o[c2][dt][4 * rr + 2] * inv; v[3] = o[c2][dt][4 * rr + 3] * inv;
                *(u32x2*)(ob + (oo + (unsigned)(32 * dt + 8 * rr))) = pack4(v); }
      } }
}

#define XB_TMO      128
#define XB_XCNT(j)  (256  + 64 * (j))
#define XB_XSUB(j)  (1280 + 64 * (j))
#define XB_XGEN(j)  (2304 + 64 * (j))
#define XB_TOP      3328
#define XB_TOPGEN   3392
#define XCD_BAR_WORDS 3456
#define XB_SPIN_CAP (1u << 22)
__device__ __forceinline__ unsigned xb_ld(unsigned* p)              { return __hip_atomic_load(p, __ATOMIC_RELAXED, __HIP_MEMORY_SCOPE_AGENT); }
__device__ __forceinline__ unsigned xb_add(unsigned* p, unsigned v) { return __hip_atomic_fetch_add(p, v, __ATOMIC_RELAXED, __HIP_MEMORY_SCOPE_AGENT); }
__device__ __forceinline__ unsigned xb_xcc_id() { return (unsigned)__builtin_amdgcn_s_getreg((3 << 11) | 20) & 0xFu; }
#define XB_SPIN(cond, bar) do { unsigned _sp = 0; while (cond) { __builtin_amdgcn_s_sleep(1); \
    if ((++_sp & 255u) == 0u) { if (xb_ld(&(bar)[XB_TMO])) break; if (_sp > XB_SPIN_CAP) { atomicAdd(&(bar)[XB_TMO], 1u); break; } } } } while (0)
struct XcdBarrier { unsigned* bar; unsigned x; volatile LAS unsigned* st; };
__device__ __forceinline__ XcdBarrier xcd_barrier_post(unsigned* bar, volatile LAS unsigned* st, bool leader) {
    XcdBarrier b; b.bar = bar; b.x = xb_xcc_id(); b.st = st;
    if (leader) (void)xb_add(&bar[XB_XCNT(b.x)], 1u);
    return b;
}
__device__ __forceinline__ void xcd_barrier_complete(unsigned* bar, unsigned x, unsigned& nloc, unsigned& nx) {
    const unsigned G = gridDim.x;
    unsigned sum, cnt, mine, sp = 0u;
    for (;;) {
        sum = 0u; cnt = 0u; mine = 0u;
#pragma unroll
        for (unsigned j = 0; j < 16; ++j) { const unsigned c = xb_ld(&bar[XB_XCNT(j)]); sum += c; cnt += (c > 0u) ? 1u : 0u; mine = (j == x) ? c : mine; }
        if (sum == G) break;
        __builtin_amdgcn_s_sleep(1);
        if ((++sp & 255u) == 0u) { if (xb_ld(&bar[XB_TMO])) break; if (sp > XB_SPIN_CAP) { atomicAdd(&bar[XB_TMO], 1u); break; } }
    }
    nloc = mine > 0u ? mine : 1u; nx = cnt > 0u ? cnt : 1u;
}
__device__ __forceinline__ void xcd_barrier(const XcdBarrier& b, bool leader) {
    asm volatile("s_waitcnt vmcnt(0)" ::: "memory");
    __syncthreads();
    if (leader) {
        unsigned* bar = b.bar;
        __builtin_amdgcn_s_waitcnt(0);
        unsigned nloc = b.st[0], nx = b.st[1];
        if (nloc == 0u) { xcd_barrier_complete(bar, b.x, nloc, nx); b.st[0] = nloc; b.st[1] = nx; }
        const unsigned old = xb_add(&bar[XB_XSUB(b.x)], 1u);
        const unsigned gen = old / nloc;
        if (old + 1u == (gen + 1u) * nloc) {
            __builtin_amdgcn_fence(__ATOMIC_RELEASE, "agent");
            asm volatile("s_waitcnt vmcnt(0)" ::: "memory");
            const unsigned og = xb_add(&bar[XB_TOP], 1u);
            const unsigned tg = og / nx;
            if (og + 1u == (tg + 1u) * nx) xb_add(&bar[XB_TOPGEN], 1u);
            else XB_SPIN(xb_ld(&bar[XB_TOPGEN]) == tg, bar);
            __builtin_amdgcn_fence(__ATOMIC_ACQUIRE, "agent");
            xb_add(&bar[XB_XGEN(b.x)], 1u);
            asm volatile("s_waitcnt vmcnt(0)" ::: "memory");
        } else {
            XB_SPIN(xb_ld(&bar[XB_XGEN(b.x)]) == gen, bar);
            __builtin_amdgcn_fence(__ATOMIC_ACQUIRE, "agent");
            asm volatile("s_waitcnt vmcnt(0)" ::: "memory");
        }
    }
    __syncthreads();
}
constexpr int GB_CNT = 230000, GB_XID = 231000;
constexpr int GW_CNT0 = 232000;
__device__ __forceinline__ void grp_barrier(unsigned* ctl, const XcdBarrier& bar, const unsigned mode, const unsigned gen, bool leader, const int arrive = -1, const int wait = -1) {
    asm volatile("s_waitcnt vmcnt(0)" ::: "memory");
    __syncthreads();
    if (leader) {
        unsigned* cnt = ctl + GB_CNT + 64 * (blockIdx.x & 7);
        if (!(mode & 2u)) { __builtin_amdgcn_fence(__ATOMIC_RELEASE, "agent"); asm volatile("s_waitcnt vmcnt(0)" ::: "memory"); }
        __builtin_amdgcn_s_waitcnt(0);
        if (arrive >= 0) (void)xb_add(ctl + GW_CNT0 + 64 * arrive, 1u);
        (void)xb_add(cnt, 1u);
        const unsigned target = 32u * gen;
        XB_SPIN(xb_ld(cnt) < target, bar.bar);
        if (wait >= 0) { unsigned* wc = ctl + GW_CNT0 + 64 * wait; XB_SPIN(xb_ld(wc) < gridDim.x, bar.bar); }
        __builtin_amdgcn_fence(__ATOMIC_ACQUIRE, "agent");
        asm volatile("s_waitcnt vmcnt(0)" ::: "memory");
    }
    __syncthreads();
}

typedef float f32x4v __attribute__((ext_vector_type(4)));
constexpr int ML_QS = 0, ML_KS = 17408, ML_KGT = 34816, ML_VT = 53248, ML_PS = 71680, ML_A = 80896, ML_PM = 89088, ML_BC = 97280, ML_N = 105472, ML_DEN = 105984, ML_SCAN = 106240, ML_END = 106496;
constexpr int ML_HS = 106496;
constexpr int ML_GM = 145408;
constexpr int ML_CW = 140288;
constexpr int ML_QLD = 136, ML_TLD = 72, ML_HLD = 132;
__device__ __forceinline__ int tsw(int row, int s) { return row * ML_TLD + ((((s >> 3) ^ (row >> 3)) & 7) << 3) + (s & 7); }
__device__ __forceinline__ float wave_scan_add(float v, int lane) {
#pragma unroll
    for (int o = 1; o < 64; o <<= 1) { const float u = __shfl_up(v, o); if (lane >= o) v += u; }
    return v;
}
__device__ __forceinline__ float wave_scan_max(float v, int lane) {
#pragma unroll
    for (int o = 1; o < 64; o <<= 1) { const float u = __shfl_up(v, o); if (lane >= o) v = fmaxf(v, u); }
    return v;
}
__device__ __forceinline__ void bf8_to_f32(const u32x4 r, float (&x)[8]) {
    x[0] = __uint_as_float(r.x << 16); x[1] = __uint_as_float(r.x & 0xffff0000u); x[2] = __uint_as_float(r.y << 16); x[3] = __uint_as_float(r.y & 0xffff0000u);
    x[4] = __uint_as_float(r.z << 16); x[5] = __uint_as_float(r.z & 0xffff0000u); x[6] = __uint_as_float(r.w << 16); x[7] = __uint_as_float(r.w & 0xffff0000u);
}
__device__ __forceinline__ void mlstm_item(const Bufs& B, LAS unsigned char* lds, const int b, const int h, const int wave, const int lane, const float* g_mh, const float* conv_w, const float* conv_b) {
    const int tid = wave * 64 + lane;
    const size_t rowb = (size_t)b * SEQ;
    LAS float* As = (LAS float*)(lds + ML_A); LAS float* Pms = (LAS float*)(lds + ML_PM); LAS float* Bcs = (LAS float*)(lds + ML_BC);
    LAS float* Ns = (LAS float*)(lds + ML_N); LAS float* Dens = (LAS float*)(lds + ML_DEN); LAS float* Scan = (LAS float*)(lds + ML_SCAN);
    LAS bf16_t* Qs = (LAS bf16_t*)(lds + ML_QS); LAS bf16_t* Ks = (LAS bf16_t*)(lds + ML_KS); LAS bf16_t* KgT = (LAS bf16_t*)(lds + ML_KGT);
    LAS bf16_t* VT = (LAS bf16_t*)(lds + ML_VT); LAS bf16_t* Ps = (LAS bf16_t*)(lds + ML_PS); LAS float* Hs = (LAS float*)(lds + ML_HS);
    __syncthreads();
    {
        float lf[4], li[4];
#pragma unroll
        for (int i = 0; i < 4; ++i) { lf[i] = B.MF[(rowb + 4 * tid + i) * 4 + h]; li[i] = B.MI[(rowb + 4 * tid + i) * 4 + h]; }
        float c[4]; c[0] = lf[0]; c[1] = c[0] + lf[1]; c[2] = c[1] + lf[2]; c[3] = c[2] + lf[3];
        const float inc = wave_scan_add(c[3], lane);
        if (lane == 63) Scan[wave] = inc;
        __syncthreads();
        float off = inc - c[3];
        for (int w = 0; w < wave; ++w) off += Scan[w];
        float av[4], mx[4];
#pragma unroll
        for (int i = 0; i < 4; ++i) { const float bc = off + c[i]; Bcs[4 * tid + i] = bc; av[i] = li[i] - bc; As[4 * tid + i] = av[i]; }
        mx[0] = av[0]; mx[1] = fmaxf(mx[0], av[1]); mx[2] = fmaxf(mx[1], av[2]); mx[3] = fmaxf(mx[2], av[3]);
        const float incm = wave_scan_max(mx[3], lane);
        __syncthreads();
        if (lane == 63) Scan[wave] = incm;
        __syncthreads();
        float pre = __shfl_up(incm, 1); if (lane == 0) pre = 0.f;
        for (int w = 0; w < wave; ++w) pre = fmaxf(pre, Scan[w]);
        pre = fmaxf(pre, 0.f);
#pragma unroll
        for (int i = 0; i < 4; ++i) Pms[4 * tid + i] = fmaxf(pre, mx[i]);
        if (tid < 128) Ns[tid] = 0.f;
        LAS float* Cw = (LAS float*)(lds + ML_CW);
        for (int idx = tid; idx < 1280; idx += NTHREADS) { const int t = idx / 640, j = (idx % 640) >> 7, c = idx & 127;
            Cw[idx] = j < 4 ? conv_w[j * 1024 + t * 512 + h * 128 + c] : conv_b[t * 512 + h * 128 + c]; }
        if (tid < 128) ((LAS float*)(lds + ML_GM))[tid] = g_mh[h * 128 + tid];
    }
    const int kq = wave >> 2;
    const bf16_t* s0p = (kq ? B.MQ : B.MK) + rowb * 512 + h * 128;
    const bf16_t* s1p = B.MV + rowb * 512 + h * 128;
    u32x4 raw[11];
#define ML_BAR() asm volatile("s_waitcnt lgkmcnt(0)\n\ts_barrier" ::: "memory")
#define ML_LOAD_RAW(t0_) do { const int r0_ = (t0_) + 4 * rq; \
        _Pragma("unroll") for (int i = 0; i < 7; ++i) raw[i] = (r0_ + i - 3 >= 0) ? *(const u32x4*)(s0p + (so + (unsigned)(r0_ + i - 3) * 512u)) : (u32x4){0u, 0u, 0u, 0u}; \
        if (kq) { _Pragma("unroll") for (int i = 0; i < 4; ++i) raw[7 + i] = *(const u32x4*)(s1p + (so + (unsigned)(r0_ + i) * 512u)); } } while (0)
#define ML_CONV(cc_, osc_) do { const LAS float* cwp_ = (const LAS float*)(lds + ML_CW) + (kq ? 0 : 640) + 8 * co; \
        _Pragma("unroll") for (int hq = 0; hq < 2; ++hq) { \
            f32x4v w_[5]; _Pragma("unroll") for (int j = 0; j < 5; ++j) w_[j] = *(const LAS f32x4v*)(cwp_ + j * 128 + 4 * hq); \
            f32x4v x_[7]; _Pragma("unroll") for (int i = 0; i < 7; ++i) { const unsigned lo_ = hq ? raw[i].z : raw[i].x, hi_ = hq ? raw[i].w : raw[i].y; \
                x_[i][0] = __uint_as_float(lo_ << 16); x_[i][1] = __uint_as_float(lo_ & 0xffff0000u); x_[i][2] = __uint_as_float(hi_ << 16); x_[i][3] = __uint_as_float(hi_ & 0xffff0000u); } \
            _Pragma("unroll") for (int rr = 0; rr < 4; ++rr) { f32x4v a_ = w_[4]; _Pragma("unroll") for (int j = 0; j < 4; ++j) a_ += w_[j] * x_[rr + j]; \
                _Pragma("unroll") for (int e = 0; e < 4; ++e) a_[e] = a_[e] * fast_sigmoid(a_[e]) * (osc_); \
                const unsigned p0_ = cvt_pk_bf16(a_[0], a_[1]), p1_ = cvt_pk_bf16(a_[2], a_[3]); if (hq) { cc_[rr].z = p0_; cc_[rr].w = p1_; } else { cc_[rr].x = p0_; cc_[rr].y = p1_; } } } } while (0)
    { const int rq = (tid >> 4) & 15, co = tid & 15; const unsigned so = 8u * (unsigned)co; ML_LOAD_RAW(0); }
    const bf16_t* mob = B.MO + rowb * 512 + h * 128;
    f32x4v Cacc[8];
#pragma unroll
    for (int i = 0; i < 8; ++i) Cacc[i] = (f32x4v){0.f, 0.f, 0.f, 0.f};
    __syncthreads();
#pragma unroll 1
    for (int c = 0; c < SEQ / 64; ++c) {
        const int t0 = c * 64;
        int tl = tid; asm volatile("" : "+v"(tl));
        const int rq = (tl >> 4) & 15, co = tl & 15, l15 = tl & 15, q4 = (tl >> 4) & 3, rp_t = tl >> 3, rp_part = tl & 7; const unsigned so = 8u * (unsigned)co;
        const float Rc = c == 0 ? 0.f : Pms[t0 - 1], Rn = Pms[t0 + 63];
        asm volatile("" : "+v"(raw[0]), "+v"(raw[1]), "+v"(raw[2]), "+v"(raw[3]), "+v"(raw[4]), "+v"(raw[5]), "+v"(raw[6]), "+v"(raw[7]), "+v"(raw[8]), "+v"(raw[9]), "+v"(raw[10]));
        u32x4 cc[4]; ML_CONV(cc, kq ? MLQ_SCALE : 1.f);
        if (kq == 0) {
            float gs[4];
#pragma unroll
            for (int rr = 0; rr < 4; ++rr) { gs[rr] = __expf(As[t0 + 4 * rq + rr] - Rn); *(LAS u32x4*)(Ks + (4 * rq + rr) * ML_QLD + 8 * co) = cc[rr]; }
            float kf[4][8];
#pragma unroll
            for (int rr = 0; rr < 4; ++rr) bf8_to_f32(cc[rr], kf[rr]);
#pragma unroll
            for (int i = 0; i < 8; ++i) { u32x2 w; w.x = cvt_pk_bf16(kf[0][i] * gs[0], kf[1][i] * gs[1]); w.y = cvt_pk_bf16(kf[2][i] * gs[2], kf[3][i] * gs[3]);
                *(LAS u32x2*)(KgT + tsw(8 * co + i, 4 * rq)) = w; }
        } else {
#pragma unroll
            for (int rr = 0; rr < 4; ++rr) *(LAS u32x4*)(Qs + (4 * rq + rr) * ML_QLD + 8 * co) = cc[rr];
            unsigned vv[4][4];
#pragma unroll
            for (int rr = 0; rr < 4; ++rr) { vv[rr][0] = raw[7 + rr].x; vv[rr][1] = raw[7 + rr].y; vv[rr][2] = raw[7 + rr].z; vv[rr][3] = raw[7 + rr].w; }
#pragma unroll
            for (int i = 0; i < 8; ++i) { const int wd = i >> 1; u32x2 w;
                if (i & 1) { w.x = (vv[0][wd] >> 16) | (vv[1][wd] & 0xffff0000u); w.y = (vv[2][wd] >> 16) | (vv[3][wd] & 0xffff0000u); }
                else       { w.x = (vv[0][wd] & 0xffffu) | (vv[1][wd] << 16);     w.y = (vv[2][wd] & 0xffffu) | (vv[3][wd] << 16); }
                *(LAS u32x2*)(VT + tsw(8 * co + i, 4 * rq)) = w; }
        }
        ML_BAR();
        {
            const int ti = wave >> 1;
#pragma unroll
            for (int jj = 0; jj < 2; ++jj) { const int sj = 2 * (wave & 1) + jj;
                f32x4v acc = {0.f, 0.f, 0.f, 0.f};
#pragma unroll
                for (int ks = 0; ks < 4; ++ks) { const bf16x8 af = *(const LAS bf16x8*)(Qs + (16 * ti + l15) * ML_QLD + 32 * ks + 8 * q4), bfr = *(const LAS bf16x8*)(Ks + (16 * sj + l15) * ML_QLD + 32 * ks + 8 * q4);
                    acc = __builtin_amdgcn_mfma_f32_16x16x32_bf16(af, bfr, acc, 0, 0, 0); }
                const int s = 16 * sj + l15; const float as = As[t0 + s];
#pragma unroll
                for (int r = 0; r < 4; ++r) { const int t = 16 * ti + 4 * q4 + r; const float p = s <= t ? acc[r] * __expf(as - Pms[t0 + t]) : 0.f; Ps[t * ML_TLD + s] = f2bf(p); }
            }
        }
        ML_BAR();
        {
            const int t = tid >> 3, part = tid & 7; float qn = 0.f, ps = 0.f;
            float qv[8], qw[8]; bf8_to_f32(*(const LAS u32x4*)(Qs + t * ML_QLD + 16 * part), qv); bf8_to_f32(*(const LAS u32x4*)(Qs + t * ML_QLD + 16 * part + 8), qw);
            const f32x4v n0 = *(const LAS f32x4v*)(Ns + 16 * part), n1 = *(const LAS f32x4v*)(Ns + 16 * part + 4), n2 = *(const LAS f32x4v*)(Ns + 16 * part + 8), n3 = *(const LAS f32x4v*)(Ns + 16 * part + 12);
#pragma unroll
            for (int i = 0; i < 4; ++i) qn += qv[i] * n0[i] + qv[4 + i] * n1[i] + qw[i] * n2[i] + qw[4 + i] * n3[i];
            float pv8[8]; bf8_to_f32(*(const LAS u32x4*)(Ps + t * ML_TLD + 8 * part), pv8);
#pragma unroll
            for (int i = 0; i < 8; ++i) ps += pv8[i];
            qn += __shfl_xor(qn, 1); qn += __shfl_xor(qn, 2); qn += __shfl_xor(qn, 4);
            ps += __shfl_xor(ps, 1); ps += __shfl_xor(ps, 2); ps += __shfl_xor(ps, 4);
            if (part == 0) { const float den = __expf(Rc - Pms[t0 + t]) * qn + ps; Dens[t] = 1.f / fmaxf(fabsf(den), __expf(-(Bcs[t0 + t] + Pms[t0 + t]))); }
        }
        f32x4v no[4];
#pragma unroll
        for (int ti = 0; ti < 4; ++ti) no[ti] = (f32x4v){0.f, 0.f, 0.f, 0.f};
        if (c > 0) {
#pragma unroll
            for (int kk = 0; kk < 4; ++kk) {
                u32x4 cb4; cb4.x = cvt_pk_bf16(Cacc[2 * kk][0], Cacc[2 * kk][1]); cb4.y = cvt_pk_bf16(Cacc[2 * kk][2], Cacc[2 * kk][3]); cb4.z = cvt_pk_bf16(Cacc[2 * kk + 1][0], Cacc[2 * kk + 1][1]); cb4.w = cvt_pk_bf16(Cacc[2 * kk + 1][2], Cacc[2 * kk + 1][3]);
                const bf16x8 cfrag = __builtin_bit_cast(bf16x8, cb4);
#pragma unroll
                for (int ti = 0; ti < 4; ++ti) { const LAS bf16_t* qp = Qs + (16 * ti + l15) * ML_QLD + 32 * kk + 4 * q4;
                    const u32x2 lo = *(const LAS u32x2*)qp, hi = *(const LAS u32x2*)(qp + 16);
                    u32x4 x; x.x = lo.x; x.y = lo.y; x.z = hi.x; x.w = hi.y;
                    no[ti] = __builtin_amdgcn_mfma_f32_16x16x32_bf16(__builtin_bit_cast(bf16x8, x), cfrag, no[ti], 0, 0, 0); }
            }
#pragma unroll
            for (int ti = 0; ti < 4; ++ti) { const f32x4v pm4 = *(const LAS f32x4v*)(Pms + t0 + 16 * ti + 4 * q4);
#pragma unroll
                for (int r = 0; r < 4; ++r) no[ti][r] *= __expf(Rc - pm4[r]); }
        }
        const bf16x8 vfr0 = *(const LAS bf16x8*)(VT + tsw(16 * wave + l15, 8 * q4)), vfr1 = *(const LAS bf16x8*)(VT + tsw(16 * wave + l15, 32 + 8 * q4));
#pragma unroll
        for (int ti = 0; ti < 4; ++ti) { const bf16x8 pf0 = *(const LAS bf16x8*)(Ps + (16 * ti + l15) * ML_TLD + 8 * q4), pf1 = *(const LAS bf16x8*)(Ps + (16 * ti + l15) * ML_TLD + 32 + 8 * q4);
            no[ti] = __builtin_amdgcn_mfma_f32_16x16x32_bf16(pf0, vfr0, no[ti], 0, 0, 0); no[ti] = __builtin_amdgcn_mfma_f32_16x16x32_bf16(pf1, vfr1, no[ti], 0, 0, 0); }
        ML_BAR();
        u32x4 mo_cur[2]; { const unsigned moo = (unsigned)((t0 + rp_t) * 512 + 16 * rp_part); mo_cur[0] = *(const u32x4*)(mob + moo); mo_cur[1] = *(const u32x4*)(mob + (moo + 8u)); }
        if (c + 1 < SEQ / 64) ML_LOAD_RAW(t0 + 64);
#pragma unroll
        for (int ti = 0; ti < 4; ++ti)
#pragma unroll
            for (int r = 0; r < 4; ++r) Hs[(16 * ti + 4 * q4 + r) * ML_HLD + 16 * wave + l15] = no[ti][r];
        {
            const float decay = __expf(Rc - Rn);
#pragma unroll
            for (int dt = 0; dt < 8; ++dt) Cacc[dt] = Cacc[dt] * decay;
#pragma unroll
            for (int dt = 0; dt < 8; ++dt) { const bf16x8 kf0 = *(const LAS bf16x8*)(KgT + tsw(16 * dt + l15, 8 * q4)), kf1 = *(const LAS bf16x8*)(KgT + tsw(16 * dt + l15, 32 + 8 * q4));
                Cacc[dt] = __builtin_amdgcn_mfma_f32_16x16x32_bf16(kf0, vfr0, Cacc[dt], 0, 0, 0); Cacc[dt] = __builtin_amdgcn_mfma_f32_16x16x32_bf16(kf1, vfr1, Cacc[dt], 0, 0, 0); }
            { const int d = tid >> 2, part = tid & 3; float kv[8], kw[8]; bf8_to_f32(*(const LAS u32x4*)(KgT + tsw(d, 16 * part)), kv); bf8_to_f32(*(const LAS u32x4*)(KgT + tsw(d, 16 * part + 8)), kw);
              float s = 0.f;
#pragma unroll
              for (int i = 0; i < 8; ++i) s += kv[i] + kw[i];
              s += __shfl_xor(s, 1); s += __shfl_xor(s, 2);
              if (part == 0) Ns[d] = decay * Ns[d] + s; }
        }
        ML_BAR();
        {
            const int t = tid >> 3, part = tid & 7; const float inv = Dens[t];
            const LAS f32x4v* hp = (const LAS f32x4v*)(Hs + t * ML_HLD + 16 * part);
            f32x4v hq[4]; float sq = 0.f;
#pragma unroll
            for (int i = 0; i < 4; ++i) { hq[i] = hp[i] * inv; sq += dot4(hq[i]); }
            sq += __shfl_xor(sq, 1); sq += __shfl_xor(sq, 2); sq += __shfl_xor(sq, 4);
            const float rs = rsqrtf(sq * (1.f / 128.f) + EPS);
            const size_t row = rowb + t0 + t;
            float mo[8], mo2[8];
            bf8_to_f32(mo_cur[0], mo); bf8_to_f32(mo_cur[1], mo2);
            f32x4v o0, o1, o2, o3;
            const LAS f32x4v* gp = (const LAS f32x4v*)(lds + ML_GM) + 4 * part; const f32x4v g0 = gp[0], g1 = gp[1], g2 = gp[2], g3 = gp[3];
#pragma unroll
            for (int i = 0; i < 4; ++i) { o0[i] = hq[0][i] * rs * g0[i] * mo[i]; o1[i] = hq[1][i] * rs * g1[i] * mo[4 + i]; o2[i] = hq[2][i] * rs * g2[i] * mo2[i]; o3[i] = hq[3][i] * rs * g3[i] * mo2[4 + i]; }
            bf16_t* op = B.MIX + row * 1024 + 512 + h * 128 + 16 * part;
            *(u32x4*)op = pack8(o0, o1); *(u32x4*)(op + 8) = pack8(o2, o3);
        }
    }
#undef ML_LOAD_RAW
#undef ML_CONV
#undef ML_BAR
}

__device__ __forceinline__ void phase_idxml(const Args& a, const Bufs& B, LAS unsigned char* lds, int L, int rep, int bid, int G, int wave, int lane, bool grp) {
    const int x = grp ? (bid & 7) : 0, rank = grp ? (bid >> 3) : bid, nrank = grp ? 32 : G, dsh = grp ? 1 : 4, bb = x << dsh, nml = 4 << dsh, nit = 128 << dsh;
#pragma unroll 1
    for (int item = rank; item < nml; item += nrank) mlstm_item(B, lds, bb + (item >> 2), item & 3, wave, lane, a.in[15] + L * 512, a.in[11] + (size_t)L * 4 * 1024, a.in[12] + L * 1024);
    { unsigned m1 = ~0u; asm volatile("" : "+s"(m1)); lane = (int)__builtin_amdgcn_mbcnt_hi(m1, __builtin_amdgcn_mbcnt_lo(m1, 0u)); }
    unsigned* qctr = (unsigned*)(a.ws + WS_CTL) + 220000 + 64 * (8 * (L + 2 * rep) + x);
    volatile LAS int* slot = (volatile LAS int*)(lds + LDS_BYTES - 128);
    const bool ldr = (wave == 0) && (lane == 0);
    __syncthreads();
    if (ldr) slot[0] = (int)__hip_atomic_fetch_add(qctr, 1u, __ATOMIC_RELAXED, __HIP_MEMORY_SCOPE_AGENT);
    __syncthreads();
    int it = __builtin_amdgcn_readfirstlane(slot[0]), cur = 0;
    IdxPre P, Pn;
    if (it < nit) idx_preload(P, B, bb + (it & ((1 << dsh) - 1)), 127 - (it >> dsh), wave, lane);
    while (it < nit) {
        int nxt = 0;
        if (ldr) nxt = (int)__hip_atomic_fetch_add(qctr, 1u, __ATOMIC_RELAXED, __HIP_MEMORY_SCOPE_AGENT);
        it = idx_wg_item(B, lds, bb + (it & ((1 << dsh) - 1)), 127 - (it >> dsh), wave, lane, P, Pn, slot + 1 + cur, ldr, nxt, dsh, bb);
        P = Pn; cur ^= 1;
    }
}
__device__ __forceinline__ void phase_mix(const Args& a, const Bufs& B, LAS unsigned char* lds, int L, int rep, int bid, int G, int wave, int lane, bool grp) {
#ifndef PROBE_ML
#define PROBE_ML 1
#endif
#ifndef PROBE_ATT
#define PROBE_ATT 1
#endif
#ifdef PROBE_SKIP
    const bool pfx = (a.bar_slot == 0);
#else
    const bool pfx = false;
#endif
#ifndef PROBE_SKIP
#define PROBE_SKIP 0
#endif
    (void)pfx;
#pragma unroll 1
    for (int r = 0; r < PROBE_ATT; ++r) {
        if (pfx && PROBE_SKIP == 1) break;
        const int x = grp ? (bid & 7) : 0, dsh = grp ? 1 : 4, bb = x << dsh, nit = 32 << dsh;
        unsigned* qctr = (unsigned*)(a.ws + WS_CTL) + 200000 + 64 * (8 * (L + 2 * r) + x);
        for (;;) {
            int so = LDS_BYTES - 128; unsigned m1 = ~0u; asm volatile("" : "+s"(so), "+s"(m1));
            volatile LAS int* slot = (volatile LAS int*)(lds + so); lane = (int)__builtin_amdgcn_mbcnt_hi(m1, __builtin_amdgcn_mbcnt_lo(m1, 0u));
            __syncthreads();
            if (wave == 0 && lane == 0) slot[0] = (int)__hip_atomic_fetch_add(qctr, 1u, __ATOMIC_RELAXED, __HIP_MEMORY_SCOPE_AGENT);
            __syncthreads();
            const int it = __builtin_amdgcn_readfirstlane(slot[0]);
            if (it >= nit) break;
            const int b = bb + (it & ((1 << dsh) - 1)), qb = 31 - (it >> dsh);
            att_wg_item(B, lds, b, qb, wave, lane);
        }
    }
}
constexpr int PH_PER_LAYER = 9, PH_TOTAL = 1 + DEPTH * PH_PER_LAYER;
__host__ __device__ __forceinline__ Bufs make_bufs(unsigned char* ws, float* out) {
    Bufs B;
    B.HB = (bf16_t*)(ws + WS_HB); B.SS = (float*)(ws + WS_SS); B.ROPE = (float*)(ws + WS_ROPE); B.CQ = (bf16_t*)(ws + WS_CQ); B.CQSS = (float*)(ws + WS_CQSS);
    B.IW = (float*)(ws + WS_IW); B.MI = (float*)(ws + WS_MI); B.MF = (float*)(ws + WS_MF); B.K = (bf16_t*)(ws + WS_K); B.VT = (bf16_t*)(ws + WS_VT);
    B.IK = (bf16_t*)(ws + WS_IK); B.SEL = (unsigned*)(ws + WS_SEL); B.Q = (bf16_t*)(ws + WS_Q); B.IQ = (bf16_t*)(ws + WS_IQ); B.MQ = (bf16_t*)(ws + WS_MQ);
    B.MK = (bf16_t*)(ws + WS_MK); B.MV = (bf16_t*)(ws + WS_MV); B.MO = (bf16_t*)(ws + WS_MO); B.MIX = (bf16_t*)((unsigned char*)out + 64 * MiB); B.PW0 = (bf16_t*)(ws + WS_PW0); B.PW1 = (bf16_t*)(ws + WS_PW1) - (size_t)PW_SPLIT_PM * 256 * DM;
    B.PB = (bf16_t*)(ws + WS_PB); B.U = (bf16_t*)(ws + WS_U);
    return B;
}

#ifndef REPEAT_MASK
#define REPEAT_MASK 0
#endif
#define PH_REP(k) for (int rep_ = 0; rep_ < (((REPEAT_MASK >> (k)) & 1) ? 2 : 1); ++rep_)
#define PH_IN(p) (lo <= (p) && (p) < hi)
#define PH_SYNC(p) do { if ((p) > lo) xcd_barrier(bar, leader); } while (0)
#define PH_GSYNC(p, idx, arr, wt) do { if ((p) > lo) { const unsigned gm_ = (unsigned)__builtin_amdgcn_readfirstlane((int)bar.st[2]); if (gm_ & 1u) grp_barrier((unsigned*)(a.ws + WS_CTL), bar, gm_, (unsigned)(L * 7 + (idx)), leader, (arr), (wt)); else xcd_barrier(bar, leader); } } while (0)
template <int L>
__device__ __forceinline__ void layer_phases(const Args& a, LAS unsigned char* lds, const XcdBarrier& bar, const int wave, const int lo, const int hi) {
    constexpr int pb = 1 + L * PH_PER_LAYER;
    const int G = gridDim.x, bid = blockIdx.x; const bool leader = (wave == 0) && (__lane_id() == 0);
    if (PH_IN(pb + 0)) { PH_SYNC(pb + 0);
        if (L == 0) {
            const bool use = (gridDim.x == 256u && lo == 0); unsigned* ctl = (unsigned*)(a.ws + WS_CTL);
            if (wave == 0) { unsigned m1 = ~0u; asm volatile("" : "+s"(m1)); const int ln = (int)__builtin_amdgcn_mbcnt_hi(m1, __builtin_amdgcn_mbcnt_lo(m1, 0u));
                const unsigned id = use ? xb_ld(&ctl[GB_XID + (blockIdx.x & 7) + 8 * (ln & 31)]) : 0u; const bool same = (id == xb_xcc_id() + 1u); if (ln == 0) bar.st[2] = use ? (__all(same) ? 3u : 1u) : 0u; }
            __syncthreads();
        }
        PH_REP(0) {
        const Bufs B = make_bufs(a.ws, a.out); unsigned char* wb = a.ws + WS_W + (size_t)L * W_LSTRIDE; pg8::StaticOrder S;
        pg8::Gemm g{(const bf16_t*)a.out, (const bf16_t*)(wb + WO_IN), M, NPROJ, DM}; S.init(M, NPROJ, G, bid);
        EpiProj E{B, B.SS, a.in[9] + L * 64, a.in[10] + L * 64, a.in[13] + L * 4, a.in[14] + L * 4}; pg8::gemm_phase(lds, g, S, E, wave); } }
    if (PH_IN(pb + 1)) { PH_GSYNC(pb + 1, 1, -1, -1); PH_REP(1) {
        const Bufs B = make_bufs(a.ws, a.out); unsigned char* wb = a.ws + WS_W + (size_t)L * W_LSTRIDE; pg8::StaticOrder S;
        pg8::Gemm g{B.CQ, (const bf16_t*)(wb + WO_QUP), M, 1024, QR}; S.init(M, 1024, G, bid);
        EpiQup E{B, a.in[8] + L * 64, (const int*)a.in[2]}; pg8::gemm_phase(lds, g, S, E, wave); } }
    if (PH_IN(pb + 2)) { PH_GSYNC(pb + 2, 2, -1, -1); PH_REP(2) {
        const Bufs B = make_bufs(a.ws, a.out); phase_idxml(a, B, lds, L, rep_, bid, G, wave, (int)__lane_id(), (__builtin_amdgcn_readfirstlane((int)bar.st[2]) & 1) != 0); } }
    if (PH_IN(pb + 3)) { PH_GSYNC(pb + 3, 3, -1, -1); PH_REP(3) {
        const Bufs B = make_bufs(a.ws, a.out);
        phase_mix(a, B, lds, L, rep_, bid, G, wave, (int)__lane_id(), (__builtin_amdgcn_readfirstlane((int)bar.st[2]) & 1) != 0);
        } }
    if (PH_IN(pb + 4)) { PH_GSYNC(pb + 4, 4, L, -1); PH_REP(4) {
        const Bufs B = make_bufs(a.ws, a.out); unsigned char* wb = a.ws + WS_W + (size_t)L * W_LSTRIDE; pg8::StaticOrder S;
        pg8::Gemm g{B.MIX, (const bf16_t*)(wb + WO_OUT), M, DM, DM}; S.init(M, DM, G, bid);
#ifdef PROBE_WOUT
        { EpiRes E0{L == 0 ? a.in[0] : a.out, (float*)B.U, B.U + (size_t)M * 2048, B.SS + (size_t)2 * M * 16}; pg8::gemm_phase(lds, g, S, E0, wave); }
#endif
        { EpiResB<false> E{(const bf16_t*)a.out, B.HB, B.SS + (size_t)M * 16}; pg8::gemm_phase(lds, g, S, E, wave); } } }
    if (PH_IN(pb + 5)) { PH_GSYNC(pb + 5, 5, (L + 1 < DEPTH) ? -1 : 2, L); PH_REP(5) {
        const Bufs B = make_bufs(a.ws, a.out); unsigned char* wb = a.ws + WS_W + (size_t)L * W_LSTRIDE; pg8::StaticOrder S;
        pg8::Gemm g{B.HB, (const bf16_t*)(wb + WO_F1), M, DFF, DM}; S.init(M, DFF, G, bid);
        EpiFF1 E{B.SS + (size_t)M * 16, B.U}; pg8::gemm_phase(lds, g, S, E, wave); } }
    if (PH_IN(pb + 6)) { PH_GSYNC(pb + 6, 6, -1, -1); PH_REP(6) {
        const Bufs B = make_bufs(a.ws, a.out); unsigned char* wb = a.ws + WS_W + (size_t)L * W_LSTRIDE; pg8::StaticOrder S;
        pg8::Gemm g{B.U, (const bf16_t*)(wb + WO_F2), M, DM, DFF}; S.init(M, DM, G, bid); S.rev = true;
        EpiResB<false> E{B.HB, B.HB, B.SS + (size_t)2 * M * 16}; pg8::gemm_phase<EpiResB<false>, true>(lds, g, S, E, wave); } }
    if (PH_IN(pb + 7)) { PH_REP(7) {
        const Bufs B = make_bufs(a.ws, a.out); unsigned char* wb = a.ws + WS_W + (size_t)L * W_LSTRIDE; pg8::StaticOrder S;
        pg8::Gemm g{B.PB + (size_t)L * M * PLE, (const bf16_t*)(wb + WO_P), M, DM, PLE}; S.init(M, DM, G, bid);
        EpiPW E{B.PW0, B.PW1}; pg8::gemm_phase(lds, g, S, E, wave); } }
    if (PH_IN(pb + 8)) { PH_GSYNC(pb + 8, 7, -1, (L + 1 < DEPTH) ? -1 : 2); PH_REP(8) {
        const Bufs B = make_bufs(a.ws, a.out); unsigned char* wb = a.ws + WS_W + (size_t)L * W_LSTRIDE; pg8::StaticOrder S;
        pg8::Gemm g{B.HB, (const bf16_t*)(wb + WO_G), M, DM, DM}; S.init(M, DM, G, bid);
        if (L + 1 < DEPTH) { EpiGateB<false> E{B.SS + (size_t)2 * M * 16, a.in[22] + L * DM, B.PW0, B.PW1, B.HB, nullptr, (bf16_t*)a.out, B.SS}; pg8::gemm_phase(lds, g, S, E, wave); }
        else { EpiGateB<true> E{B.SS + (size_t)2 * M * 16, a.in[22] + L * DM, B.PW0, B.PW1, B.HB, a.out, nullptr, nullptr}; pg8::gemm_phase(lds, g, S, E, wave); } } }
}

__global__ void __launch_bounds__(NTHREADS, 2) mega(Args a) {
    extern __shared__ __attribute__((aligned(16))) unsigned char lds_raw[];
    LAS unsigned char* lds = (LAS unsigned char*)lds_raw;
    const int wave = __builtin_amdgcn_readfirstlane((int)(threadIdx.x >> 6));
    const bool leader = (wave == 0) && (__lane_id() == 0);
    volatile LAS unsigned* st = (volatile LAS unsigned*)(lds + LDS_BYTES - 64);
    if (leader) { st[0] = 0u; st[1] = 0u; }
    __syncthreads();
    const XcdBarrier bar = xcd_barrier_post((unsigned*)(a.ws + WS_CTL) + a.bar_slot * XCD_BAR_WORDS, st, leader);
    cg::this_grid().sync();
    const int lo = a.ph_lo, hi = a.ph_hi;
    if (leader) { unsigned xv = xb_xcc_id() + 1u; (void)xb_add((unsigned*)(a.ws + WS_CTL) + GB_XID + blockIdx.x, xv); }
#ifdef PROBE_BAR
#pragma unroll 1
    for (int i = 0; i < PROBE_BAR; ++i) xcd_barrier(bar, leader);
#endif
#ifndef PROBE_P0
#define PROBE_P0 1
#endif
    if (PH_IN(0)) for (int rep_ = 0; rep_ < PROBE_P0; ++rep_) { const Bufs B = make_bufs(a.ws, a.out); phase_prologue(a, B, lds, blockIdx.x * NWAVES + wave, gridDim.x * NWAVES, wave, (int)__lane_id()); }
    layer_phases<0>(a, lds, bar, wave, lo, hi);
    layer_phases<1>(a, lds, bar, wave, lo, hi);
}

static int g_grid = 0;
static int g_slot = 0;
static void launch_mega(const Args& base, int lo, int hi, hipStream_t stream) {
    Args a = base; a.ph_lo = lo; a.ph_hi = hi; a.bar_slot = g_slot++;
    void* args[] = {&a};
    hipError_t e = hipLaunchCooperativeKernel((const void*)mega, dim3(g_grid), dim3(NTHREADS), args, LDS_BYTES, stream);
    if (e != hipSuccess) fprintf(stderr, "kernel_launch: cooperative launch [%d,%d) failed: %s (grid %d)\n", lo, hi, hipGetErrorString(e), g_grid);
}

extern "C" void kernel_launch(void* const* d_in, const int* in_sizes, int n_in, void* d_out, int out_size, void* d_ws, size_t ws_size, hipStream_t stream) {
    if (n_in != 24 || ws_size < WS_END) { fprintf(stderr, "kernel_launch: unexpected n_in %d or ws %zu\n", n_in, ws_size); return; }
    if (g_grid == 0) {
        int dev = 0, cus = 0, per_cu = 0;
        hipGetDevice(&dev); hipDeviceGetAttribute(&cus, hipDeviceAttributeMultiprocessorCount, dev);
        if (hipFuncSetAttribute((const void*)mega, hipFuncAttributeMaxDynamicSharedMemorySize, LDS_BYTES) != hipSuccess) { fprintf(stderr, "kernel_launch: hipFuncSetAttribute failed\n"); g_grid = -1; return; }
        if (hipOccupancyMaxActiveBlocksPerMultiprocessor(&per_cu, (const void*)mega, NTHREADS, LDS_BYTES) != hipSuccess || per_cu < 1) { fprintf(stderr, "kernel_launch: occupancy query failed (%d)\n", per_cu); g_grid = -1; return; }
        g_grid = cus * per_cu;
        fprintf(stderr, "kernel_launch: %d CUs x %d blocks/CU -> grid %d\n", cus, per_cu, g_grid);
    }
    if (g_grid < 0) return;
    float* OUT = (float*)d_out; unsigned char* ws = (unsigned char*)d_ws;
    Args a{};
    for (int i = 0; i < 24; ++i) a.in[i] = (const float*)d_in[i];
    a.out = OUT; a.ws = ws;

    g_slot = 0;
    if (hipMemsetAsync(ws + WS_CTL, 0, 1 * MiB, stream) != hipSuccess) { fprintf(stderr, "kernel_launch: memset failed\n"); return; }
#ifdef PROBE_PREFIX
    launch_mega(a, 0, PROBE_PREFIX, stream);
    if (hipMemsetAsync(ws + WS_CTL, 0, 1 * MiB, stream) != hipSuccess) return;
#endif
    launch_mega(a, 0, PH_TOTAL, stream);
}
```

```cpp
#include <hip/hip_runtime.h>
#include <cstdint>
#include <cstdio>
#include <cmath>
#include <hip/hip_cooperative_groups.h>
namespace cg = cooperative_groups;

constexpr int DM = 1024, BATCH = 16, SEQ = 2048, DEPTH = 2, M = BATCH * SEQ;
constexpr int PLE = 256, QR = 256, TOPK = 256, DFF = 4096, IN_W = 2640;
constexpr int C_CQ = 0, C_AK = 256, C_AV = 384, C_IK = 512, C_IW = 576, C_MQ = 584, C_MK = 1096, C_MV = 1608, C_MO = 2120, C_MI = 2632, C_MF = 2636;
constexpr float EPS = 1e-6f;
constexpr float IDX_SCALE = 0.04419417382415922f;
constexpr float QSCALE = 0.125f * 1.4426950408889634f;
constexpr float MLQ_SCALE = 0.08838834764831845f;

typedef uint16_t bf16_t;
__device__ __forceinline__ float bf2f(bf16_t v) { return __uint_as_float(((unsigned)v) << 16); }
__device__ __forceinline__ bf16_t f2bf(float f) { unsigned u = __float_as_uint(f); return (bf16_t)((u + 0x7fffu + ((u >> 16) & 1u)) >> 16); }

constexpr size_t MiB = 1u << 20;
constexpr size_t WS_HB = 0;
constexpr size_t WS_SS = 64 * MiB;
constexpr size_t WS_ROPE = 70 * MiB;
constexpr size_t WS_CQ = 72 * MiB;
constexpr size_t WS_CQSS = 88 * MiB;
constexpr size_t WS_IW = 89 * MiB;
constexpr size_t WS_MI = 90 * MiB;
constexpr size_t WS_MF = 91 * MiB;
constexpr size_t WS_K = 92 * MiB;
constexpr size_t WS_VT = 100 * MiB;
constexpr size_t WS_IK = 108 * MiB;
constexpr size_t WS_SEL = 112 * MiB;
constexpr size_t WS_Q = 120 * MiB;
constexpr size_t WS_IQ = 152 * MiB;
constexpr size_t WS_MQ = 184 * MiB;
constexpr size_t WS_MK = 216 * MiB;
constexpr size_t WS_MV = 248 * MiB;
constexpr size_t WS_MO = 280 * MiB;
constexpr size_t WS_PW0 = 72 * MiB;
constexpr size_t WS_PW1 = 472 * MiB;
constexpr int PW_SPLIT_PM = 96;
constexpr size_t WS_PB = 440 * MiB;
constexpr size_t WS_U = 120 * MiB;
constexpr size_t WS_END = 488 * MiB;

struct Bufs {
    bf16_t *HB, *CQ, *K, *VT, *IK, *Q, *IQ, *MQ, *MK, *MV, *MO, *MIX, *PW0, *PW1, *PB, *U;
    float *SS, *ROPE, *CQSS, *IW, *MI, *MF; unsigned* SEL;
};

__device__ __forceinline__ float wave_sum(float v) {
#pragma unroll
    for (int o = 1; o < 64; o <<= 1) v += __shfl_xor(v, o);
    return v;
}
__device__ __forceinline__ float sigmoidf_(float x) { return 1.f / (1.f + __expf(-x)); }
__device__ __forceinline__ float logsigmoidf_(float x) { return fminf(x, 0.f) - log1pf(__expf(-fabsf(x))); }
__device__ __forceinline__ float rs_from_ss(const float* ss16) {
    float s = 0.f;
#pragma unroll
    for (int i = 0; i < 16; ++i) s += ss16[i];
    return rsqrtf(s * (1.f / 1024.f) + EPS);
}

__device__ __forceinline__ unsigned f2ord(float f) { const unsigned u = __float_as_uint(f); return (u & 0x80000000u) ? ~u : (u | 0x80000000u); }

#define LAS __attribute__((address_space(3)))
typedef short bf16x8 __attribute__((ext_vector_type(8)));
typedef float f32x4 __attribute__((ext_vector_type(4)));
typedef float f32x2 __attribute__((ext_vector_type(2)));
typedef unsigned u32x4 __attribute__((ext_vector_type(4)));
typedef unsigned u32x2 __attribute__((ext_vector_type(2)));

constexpr int NWAVES = 8, NTHREADS = 512;
constexpr int LDS_BYTES = 147456;

constexpr size_t WS_W = 376 * MiB, W_LSTRIDE = 28 * MiB;
constexpr size_t WO_IN = 0, WO_QUP = 6 * MiB, WO_OUT = 7 * MiB, WO_F1 = 9 * MiB, WO_F2 = 17 * MiB, WO_G = 25 * MiB, WO_P = 27 * MiB;
constexpr size_t WS_CTL = 432 * MiB;
constexpr int NPROJ = 2816;

__device__ __forceinline__ unsigned cvt_pk_bf16(float lo, float hi) { unsigned r; asm volatile("v_cvt_pk_bf16_f32 %0, %1, %2" : "=v"(r) : "v"(lo), "v"(hi)); return r; }
__device__ __forceinline__ u32x4 pack8(const f32x4 a, const f32x4 b) { u32x4 w; w.x = cvt_pk_bf16(a[0], a[1]); w.y = cvt_pk_bf16(a[2], a[3]); w.z = cvt_pk_bf16(b[0], b[1]); w.w = cvt_pk_bf16(b[2], b[3]); return w; }
__device__ __forceinline__ u32x2 pack4(const f32x4 a) { u32x2 w; w.x = cvt_pk_bf16(a[0], a[1]); w.y = cvt_pk_bf16(a[2], a[3]); return w; }
__device__ __forceinline__ float dot4(const f32x4 a) { return (a[0] * a[0] + a[1] * a[1]) + (a[2] * a[2] + a[3] * a[3]); }
__device__ __forceinline__ float red_fq(float s) { s += __shfl_xor(s, 16); s += __shfl_xor(s, 32); return s; }
__device__ __forceinline__ float fast_sigmoid(float x) { return __builtin_amdgcn_rcpf(1.f + __builtin_amdgcn_exp2f(-1.4426950408889634f * x)); }
__device__ __forceinline__ f32x4 sig4(const f32x4 v) { f32x4 o; o[0] = fast_sigmoid(v[0]); o[1] = fast_sigmoid(v[1]); o[2] = fast_sigmoid(v[2]); o[3] = fast_sigmoid(v[3]); return o; }
__host__ __device__ __forceinline__ int dimmap(int pos) { return pos < 16 ? ((pos & 3) | ((pos & 4) << 1) | ((pos & 8) >> 1)) : pos; }

namespace pg8 {
constexpr int BM = 256, BK = 64, HALF = 128, HTB = HALF * BK * 2, STAGE_BYTES = 8 * HTB, NXCD = 8, WGM = 8;
__host__ __device__ __forceinline__ int lds_byte(int r, int c) { const int st = (r >> 4) * 2 + (c >> 5), rr = r & 15, cc = c & 31, ob = rr * 64 + cc * 2; return st * 1024 + (ob ^ (((ob >> 9) & 1) << 5)); }
__host__ __device__ __forceinline__ void stage_rc(int b, int& R, int& C) { const int st = b / 1024, sb = b % 1024, swz = sb ^ (((sb >> 9) & 1) << 5); R = (st >> 1) * 16 + swz / 64; C = (st & 1) * 32 + (swz % 64) / 2; }
__host__ __device__ __forceinline__ int perm32(int rho) { const int n = rho >> 4, i = rho & 15; return 8 * (i >> 2) + 4 * n + (i & 3); }
struct Unit { int pm, pn; };
struct Gemm { const bf16_t* A; const bf16_t* Bt; int M, N, K; };
struct StaticOrder {
    int nM, nN, nwg, G, c; bool rev = false;
    __host__ __device__ void init(int M_, int N_, int G_, int c_) { nM = M_ / BM; nN = N_ / BM; nwg = nM * nN; G = G_; c = c_; }
    __host__ __device__ bool next(int i, Unit& u) const {
        const long L = (long)i * G + c; if (L >= nwg) return false;
        int wgid = (int)L; { const int q = nwg / NXCD, r = nwg % NXCD, xcd = wgid % NXCD, off = wgid / NXCD; wgid = (xcd < r ? xcd * (q + 1) : r * (q + 1) + (xcd - r) * q) + off; }
        const int nig = WGM * nN, gid = wgid / nig, fm = gid * WGM, gsz = (nM - fm) < WGM ? (nM - fm) : WGM;
        u.pm = fm + ((wgid % nig) % gsz); u.pn = (wgid % nig) / gsz; if (rev) u.pm ^= 15; return true;
    }
};
template <class Epi, bool A_TILED = false>
__device__ __forceinline__ void gemm_phase(LAS unsigned char* lds, const Gemm g, const StaticOrder& S, const Epi& E, const int wave_id) {
    int tid_ = wave_id * 64 + (int)__lane_id(); asm volatile("" : "+v"(tid_));
    const int tid = tid_, wid = __builtin_amdgcn_readfirstlane(tid >> 6), lane = tid & 63, wr = wid >> 2, wc = wid & 3, fr = lane & 15, fq = lane >> 4;
    const int K = g.K, nt = K / BK;
    unsigned voffA[2], voffB[2];
#pragma unroll
    for (int i = 0; i < 2; ++i) { int R, C; stage_rc(tid * 16 + i * 8192, R, C); const int Rb = (R & ~31) + perm32(R & 31);
        voffA[i] = (unsigned)(R * K + C) * 2u; voffB[i] = (unsigned)(Rb * K + C) * 2u;
        if (A_TILED) { const int st = (tid * 16 + i * 8192) >> 10; voffA[i] = (unsigned)((((st >> 1) * (K >> 5) + (st & 1)) << 10) + ((tid * 16) & 1023)); } }
    const size_t kstep = A_TILED ? (size_t)2048 : (size_t)(BK * 2), kstepB = (size_t)(BK * 2);
    const size_t hstep = (size_t)HALF * K * 2;
    const size_t tstep = 2 * hstep;
    const unsigned ldsw = (unsigned)wid * 1024u;
    const int aoff = lds_byte(wr * 64 + fr, fq * 8), boff = lds_byte(wc * 32 + fr, fq * 8);
#define PG8_SA(b, h) (((b) * 2 + (h)) * HTB)
#define PG8_SB(b, h) ((4 + (b) * 2 + (h)) * HTB)
#define PG8_STAGE(bufoff, gbase, voff) do { _Pragma("unroll") for (int _i = 0; _i < 2; ++_i) \
        __builtin_amdgcn_global_load_lds((const unsigned*)((const char*)(gbase) + (voff)[_i]), (LAS unsigned*)(lds + (bufoff) + ldsw + _i * 8192), 16, 0, 0); } while (0)
#define PG8_LDA(dst, b, h) do { _Pragma("unroll") for (int m = 0; m < 4; ++m) _Pragma("unroll") for (int k = 0; k < 2; ++k) dst[m][k] = *(const LAS bf16x8*)(lds + PG8_SA(b, h) + aoff + m * 2048 + k * 1024); } while (0)
#define PG8_LDB(dst, b, h) do { _Pragma("unroll") for (int n = 0; n < 2; ++n) _Pragma("unroll") for (int k = 0; k < 2; ++k) dst[n][k] = *(const LAS bf16x8*)(lds + PG8_SB(b, h) + boff + n * 2048 + k * 1024); } while (0)
#define PG8_MMA(ai, bj, At, Bt) do { __builtin_amdgcn_s_setprio(1); _Pragma("unroll") for (int m = 0; m < 4; ++m) _Pragma("unroll") for (int n = 0; n < 2; ++n) _Pragma("unroll") for (int k = 0; k < 2; ++k) \
        acc[ai][bj][m][n] = __builtin_amdgcn_mfma_f32_16x16x32_bf16(Bt[n][k], At[m][k], acc[ai][bj][m][n], 0, 0, 0); __builtin_amdgcn_s_setprio(0); } while (0)
#define PG8_WAIT_V(n) asm volatile("s_waitcnt vmcnt(" #n ")" ::: "memory")
#define PG8_WAIT_L(n) asm volatile("s_waitcnt lgkmcnt(" #n ")" ::: "memory")
#define PG8_BAR __builtin_amdgcn_s_barrier()
#define PG8_SCHED __builtin_amdgcn_sched_barrier(0)
    Unit cur, nxt; int ui = 0;
    if (!S.next(0, cur)) return;
    typename Epi::Pre pre;
    f32x4 acc[2][2][4][2];
#pragma unroll
    for (int a = 0; a < 2; ++a)
#pragma unroll
        for (int b = 0; b < 2; ++b)
#pragma unroll
            for (int m = 0; m < 4; ++m)
#pragma unroll
                for (int n = 0; n < 2; ++n) acc[a][b][m][n] = (f32x4){0.f, 0.f, 0.f, 0.f};
    bf16x8 At[4][2], B0[2][2], B1[2][2];
    const char* cA = (const char*)g.A + (size_t)cur.pm * tstep; const char* cB = (const char*)g.Bt + (size_t)cur.pn * tstep;
    PG8_STAGE(PG8_SB(0, 0), cB, voffB); PG8_STAGE(PG8_SB(0, 1), cB + hstep, voffB); PG8_STAGE(PG8_SA(0, 0), cA, voffA); PG8_STAGE(PG8_SA(0, 1), cA + hstep, voffA);
    if (wr == 1) PG8_BAR;
    PG8_WAIT_V(2); PG8_BAR;
    PG8_STAGE(PG8_SB(1, 0), cB + kstepB, voffB); PG8_STAGE(PG8_SA(1, 0), cA + kstep, voffA); PG8_STAGE(PG8_SB(1, 1), cB + hstep + kstepB, voffB);
    PG8_WAIT_V(6); PG8_BAR;
    for (;;) {
        const bool has_next = S.next(ui + 1, nxt);
        const char* nA = has_next ? (const char*)g.A + (size_t)nxt.pm * tstep : cA; const char* nB = has_next ? (const char*)g.Bt + (size_t)nxt.pn * tstep : cB;
        for (int t = 0; t < nt; t += 2) {
            const bool last = (t == nt - 2);
            if (last) E.prefetch(pre, cur, wr, wc, fr, fq);
            const char* a1 = cA + (size_t)(t + 1) * kstep;
            const char* a2 = last ? nA : cA + (size_t)(t + 2) * kstep; const char* b2 = last ? nB : cB + (size_t)(t + 2) * kstepB;
            const char* a3 = a2 + kstep; const char* b3 = b2 + kstepB;
            PG8_LDB(B0, 0, 0); PG8_LDB(B1, 0, 1); PG8_SCHED; PG8_LDA(At, 0, 0); PG8_STAGE(PG8_SA(1, 1), a1 + hstep, voffA);
            PG8_WAIT_V(8); PG8_WAIT_L(0); PG8_BAR; PG8_MMA(0, 0, At, B0); PG8_MMA(0, 1, At, B1); PG8_BAR; PG8_SCHED;
            PG8_LDA(At, 0, 1); PG8_STAGE(PG8_SB(0, 0), b2, voffB); PG8_STAGE(PG8_SB(0, 1), b2 + hstep, voffB); PG8_STAGE(PG8_SA(0, 0), a2, voffA);
            PG8_WAIT_V(8); PG8_WAIT_L(0); PG8_BAR; PG8_MMA(1, 0, At, B0); PG8_MMA(1, 1, At, B1); PG8_BAR; PG8_SCHED;
            PG8_LDB(B0, 1, 0); PG8_LDB(B1, 1, 1); PG8_SCHED; PG8_LDA(At, 1, 0); PG8_STAGE(PG8_SA(0, 1), a2 + hstep, voffA);
            PG8_WAIT_V(8); PG8_WAIT_L(0); PG8_BAR; PG8_MMA(0, 0, At, B0); PG8_MMA(0, 1, At, B1); PG8_BAR; PG8_SCHED;
            PG8_LDA(At, 1, 1); PG8_STAGE(PG8_SB(1, 0), b3, voffB); PG8_STAGE(PG8_SB(1, 1), b3 + hstep, voffB); PG8_STAGE(PG8_SA(1, 0), a3, voffA);
            PG8_WAIT_V(8); PG8_WAIT_L(0); PG8_BAR; PG8_MMA(1, 0, At, B0); PG8_MMA(1, 1, At, B1); PG8_BAR; PG8_SCHED;
        }
        if (wr == 0) PG8_BAR;
        E(acc, cur, wr, wc, fr, fq, pre);
        if (!has_next) break;
#pragma unroll
        for (int a = 0; a < 2; ++a)
#pragma unroll
            for (int b = 0; b < 2; ++b)
#pragma unroll
                for (int m = 0; m < 4; ++m)
#pragma unroll
                    for (int n = 0; n < 2; ++n) acc[a][b][m][n] = (f32x4){0.f, 0.f, 0.f, 0.f};
        cur = nxt; cA = nA; cB = nB; ++ui;
        if (wr == 1) PG8_BAR;
    }
    PG8_WAIT_V(0);
    PG8_BAR;
#undef PG8_SA
#undef PG8_SB
#undef PG8_STAGE
#undef PG8_LDA
#undef PG8_LDB
#undef PG8_MMA
#undef PG8_WAIT_V
#undef PG8_WAIT_L
#undef PG8_BAR
#undef PG8_SCHED
}
}
typedef f32x4 Acc[2][2][4][2];

__device__ __forceinline__ float row_rs16(const float* SS, int row, int fq) {
    const f32x4 s4 = *(const f32x4*)(SS + (size_t)row * 16 + 4 * fq);
    return rsqrtf(red_fq((s4[0] + s4[1]) + (s4[2] + s4[3])) * (1.f / 1024.f) + EPS);
}
__device__ __forceinline__ void rs4_load(const float* SS, int rowbase, int fq, float (&rs)[4]) {
    f32x4 s4[4];
#pragma unroll
    for (int m = 0; m < 4; ++m) s4[m] = *(const f32x4*)(SS + (size_t)(rowbase + 16 * m) * 16 + 4 * fq);
#pragma unroll
    for (int m = 0; m < 4; ++m) rs[m] = rsqrtf(red_fq((s4[m][0] + s4[m][1]) + (s4[m][2] + s4[m][3])) * (1.f / 1024.f) + EPS);
}
__device__ __forceinline__ void rs2_load(const float* SS, int rowbase, int fq, float (&rs)[2]) {
    f32x4 s4[2];
#pragma unroll
    for (int m = 0; m < 2; ++m) s4[m] = *(const f32x4*)(SS + (size_t)(rowbase + 16 * m) * 16 + 4 * fq);
#pragma unroll
    for (int m = 0; m < 2; ++m) rs[m] = rsqrtf(red_fq((s4[m][0] + s4[m][1]) + (s4[m][2] + s4[m][3])) * (1.f / 1024.f) + EPS);
}
#define EPI_FENCE() asm volatile("" ::: "memory")

struct EpiRes {
    const float* hin; float* out; bf16_t* HB; float* SSo;
    struct Pre {}; __device__ __forceinline__ void prefetch(Pre&, const pg8::Unit&, int, int, int, int) const {}
    __device__ __forceinline__ void operator()(const Acc& acc, const pg8::Unit& u, int wr, int wc, int fr, int fq, const Pre&) const {
        const int row0 = u.pm * 256 + wr * 64 + fr, col0 = u.pn * 256 + wc * 32 + 8 * fq;
#pragma unroll
        for (int ai = 0; ai < 2; ++ai) {
            f32x4 h[4][2][2];
#pragma unroll
            for (int m = 0; m < 4; ++m)
#pragma unroll
                for (int bj = 0; bj < 2; ++bj) { const size_t off = (size_t)(row0 + ai * 128 + m * 16) * DM + col0 + bj * 128; h[m][bj][0] = *(const f32x4*)(hin + off); h[m][bj][1] = *(const f32x4*)(hin + off + 4); }
#pragma unroll
            for (int m = 0; m < 4; ++m) { const int row = row0 + ai * 128 + m * 16; float sq = 0.f;
#pragma unroll
                for (int bj = 0; bj < 2; ++bj) { const size_t off = (size_t)row * DM + col0 + bj * 128;
                    const f32x4 x0 = h[m][bj][0] + acc[ai][bj][m][0], x1 = h[m][bj][1] + acc[ai][bj][m][1];
                    *(f32x4*)(out + off) = x0; *(f32x4*)(out + off + 4) = x1; *(u32x4*)(HB + off) = pack8(x0, x1); sq += dot4(x0) + dot4(x1); }
                sq = red_fq(sq); if (fq == 0) SSo[(size_t)row * 16 + u.pn * 4 + wc] = sq; }
            EPI_FENCE(); }
    }
};
__device__ __forceinline__ void bf8_unpack(const u32x4 pw, f32x4& p0, f32x4& p1) {
    p0[0] = __uint_as_float(pw.x << 16); p0[1] = __uint_as_float(pw.x & 0xffff0000u); p0[2] = __uint_as_float(pw.y << 16); p0[3] = __uint_as_float(pw.y & 0xffff0000u);
    p1[0] = __uint_as_float(pw.z << 16); p1[1] = __uint_as_float(pw.z & 0xffff0000u); p1[2] = __uint_as_float(pw.w << 16); p1[3] = __uint_as_float(pw.w & 0xffff0000u);
}
template <bool IN_F32> struct EpiResB {
    const void* hin; bf16_t* HBo; float* SSo;
    struct Pre {}; __device__ __forceinline__ void prefetch(Pre&, const pg8::Unit&, int, int, int, int) const {}
    __device__ __forceinline__ void operator()(const Acc& acc, const pg8::Unit& u, int wr, int wc, int fr, int fq, const Pre&) const {
        const int row0 = u.pm * 256 + wr * 64 + fr, col0 = u.pn * 256 + wc * 32 + 8 * fq;
        if (IN_F32) {
#pragma unroll
            for (int ai = 0; ai < 2; ++ai) {
                f32x4 h[4][2][2];
#pragma unroll
                for (int m = 0; m < 4; ++m)
#pragma unroll
                    for (int bj = 0; bj < 2; ++bj) { const size_t off = (size_t)(row0 + ai * 128 + m * 16) * DM + col0 + bj * 128; h[m][bj][0] = *(const f32x4*)((const float*)hin + off); h[m][bj][1] = *(const f32x4*)((const float*)hin + off + 4); }
#pragma unroll
                for (int m = 0; m < 4; ++m) { const int row = row0 + ai * 128 + m * 16; float sq = 0.f;
#pragma unroll
                    for (int bj = 0; bj < 2; ++bj) { const size_t off = (size_t)row * DM + col0 + bj * 128;
                        const f32x4 x0 = h[m][bj][0] + acc[ai][bj][m][0], x1 = h[m][bj][1] + acc[ai][bj][m][1];
                        *(u32x4*)(HBo + off) = pack8(x0, x1); sq += dot4(x0) + dot4(x1); }
                    sq = red_fq(sq); if (fq == 0) SSo[(size_t)row * 16 + u.pn * 4 + wc] = sq; }
                EPI_FENCE(); }
        } else {
            u32x4 hp[2][4][2];
#pragma unroll
            for (int ai = 0; ai < 2; ++ai)
#pragma unroll
                for (int m = 0; m < 4; ++m)
#pragma unroll
                    for (int bj = 0; bj < 2; ++bj) hp[ai][m][bj] = *(const u32x4*)((const bf16_t*)hin + (size_t)(row0 + ai * 128 + m * 16) * DM + col0 + bj * 128);
#pragma unroll
            for (int ai = 0; ai < 2; ++ai)
#pragma unroll
                for (int m = 0; m < 4; ++m) { const int row = row0 + ai * 128 + m * 16; float sq = 0.f;
#pragma unroll
                    for (int bj = 0; bj < 2; ++bj) { const size_t off = (size_t)row * DM + col0 + bj * 128;
                        f32x4 h0, h1; bf8_unpack(hp[ai][m][bj], h0, h1);
                        const f32x4 x0 = h0 + acc[ai][bj][m][0], x1 = h1 + acc[ai][bj][m][1];
                        *(u32x4*)(HBo + off) = pack8(x0, x1); sq += dot4(x0) + dot4(x1); }
                    sq = red_fq(sq); if (fq == 0) SSo[(size_t)row * 16 + u.pn * 4 + wc] = sq; }
        }
    }
};
struct EpiFF1 {
    const float* SS; bf16_t* U;
    struct Pre { float ps[8]; };
    __device__ __forceinline__ void prefetch(Pre& p, const pg8::Unit& u, int wr, int wc, int fr, int fq) const {
        const int row0 = u.pm * 256 + wr * 64 + fr;
#pragma unroll
        for (int i = 0; i < 8; ++i) { const f32x4 s4 = *(const f32x4*)(SS + (size_t)(row0 + (i >> 2) * 128 + (i & 3) * 16) * 16 + 4 * fq); p.ps[i] = (s4[0] + s4[1]) + (s4[2] + s4[3]); }
    }
    __device__ __forceinline__ void operator()(const Acc& acc, const pg8::Unit& u, int wr, int wc, int fr, int fq, const Pre& p) const {
        const int row0 = u.pm * 256 + wr * 64 + fr, col0 = u.pn * 256 + wc * 32 + 8 * fq;
#pragma unroll
        for (int ai = 0; ai < 2; ++ai) {
#pragma unroll
            for (int m = 0; m < 4; ++m) { const int row = row0 + ai * 128 + m * 16; const float rs = rsqrtf(red_fq(p.ps[ai * 4 + m]) * (1.f / 1024.f) + EPS);
#pragma unroll
                for (int bj = 0; bj < 2; ++bj) { f32x4 a = acc[ai][bj][m][0] * rs, b = acc[ai][bj][m][1] * rs;
#pragma unroll
                    for (int j = 0; j < 4; ++j) { a[j] = fmaxf(a[j], 0.f); a[j] *= a[j]; b[j] = fmaxf(b[j], 0.f); b[j] *= b[j]; }
                    const int row16 = row >> 4, col32 = (u.pn * 256 + bj * 128 + wc * 32) >> 5, ob = fr * 64 + 16 * fq;
                    *(u32x4*)((char*)U + (((size_t)row16 * (DFF >> 5) + col32) << 10) + (ob ^ (((ob >> 9) & 1) << 5))) = pack8(a, b); } }
            EPI_FENCE(); }
    }
};
struct EpiPW {
    bf16_t* PW0; bf16_t* PW1;
    struct Pre {}; __device__ __forceinline__ void prefetch(Pre&, const pg8::Unit&, int, int, int, int) const {}
    __device__ __forceinline__ void operator()(const Acc& acc, const pg8::Unit& u, int wr, int wc, int fr, int fq, const Pre&) const {
        const int row0 = u.pm * 256 + wr * 64 + fr, col0 = u.pn * 256 + wc * 32 + 8 * fq;
        bf16_t* PW = u.pm < PW_SPLIT_PM ? PW0 : PW1;
#pragma unroll
        for (int ai = 0; ai < 2; ++ai)
#pragma unroll
            for (int m = 0; m < 4; ++m) { const int row = row0 + ai * 128 + m * 16;
#pragma unroll
                for (int bj = 0; bj < 2; ++bj) *(u32x4*)(PW + (size_t)row * DM + col0 + bj * 128) = pack8(acc[ai][bj][m][0], acc[ai][bj][m][1]); }
    }
};
template <bool FINAL> struct EpiGateB {
    const float* SS; const float* bg; const bf16_t* PW0; const bf16_t* PW1; const bf16_t* hres; float* out; bf16_t* HBo; float* SSo;
    struct Pre {}; __device__ __forceinline__ void prefetch(Pre&, const pg8::Unit&, int, int, int, int) const {}
    __device__ __forceinline__ void operator()(const Acc& acc, const pg8::Unit& u, int wr, int wc, int fr, int fq, const Pre&) const {
        asm volatile("" : "+v"(fr), "+v"(fq));
        const int row0 = u.pm * 256 + wr * 64 + fr, col0 = u.pn * 256 + wc * 32 + 8 * fq;
        const bf16_t* PW = u.pm < PW_SPLIT_PM ? PW0 : PW1;
#pragma unroll
        for (int ai = 0; ai < 2; ++ai)
#pragma unroll
            for (int mp = 0; mp < 2; ++mp) {
                f32x4 s4[2]; u32x4 pw[2][2], hr[2][2];
#pragma unroll
                for (int mm = 0; mm < 2; ++mm) { const int row = row0 + ai * 128 + (2 * mp + mm) * 16; s4[mm] = *(const f32x4*)(SS + (size_t)row * 16 + 4 * fq);
#pragma unroll
                    for (int bj = 0; bj < 2; ++bj) { const size_t off = (size_t)row * DM + col0 + bj * 128; hr[mm][bj] = *(const u32x4*)(hres + off); pw[mm][bj] = *(const u32x4*)(PW + off); } }
#pragma unroll
                for (int mm = 0; mm < 2; ++mm) { const int m = 2 * mp + mm, row = row0 + ai * 128 + m * 16; float sq = 0.f;
                    const float rs = rsqrtf(red_fq((s4[mm][0] + s4[mm][1]) + (s4[mm][2] + s4[mm][3])) * (1.f / 1024.f) + EPS);
#pragma unroll
                    for (int bj = 0; bj < 2; ++bj) { const size_t off = (size_t)row * DM + col0 + bj * 128;
                        f32x4 p0, p1, o0, o1; bf8_unpack(pw[mm][bj], p0, p1); bf8_unpack(hr[mm][bj], o0, o1);
                        const f32x4 b0 = *(const f32x4*)(bg + col0 + bj * 128), b1 = *(const f32x4*)(bg + col0 + bj * 128 + 4);
                        const f32x4 g0 = sig4(acc[ai][bj][m][0] * rs + b0), g1 = sig4(acc[ai][bj][m][1] * rs + b1);
                        const f32x4 x0 = o0 + g0 * p0, x1 = o1 + g1 * p1;
                        if (FINAL) { *(f32x4*)(out + off) = x0; *(f32x4*)(out + off + 4) = x1; }
                        else { *(u32x4*)(HBo + off) = pack8(x0, x1); sq += dot4(x0) + dot4(x1); } }
                    if (!FINAL) { sq = red_fq(sq); if (fq == 0) SSo[(size_t)row * 16 + u.pn * 4 + wc] = sq; } }
                EPI_FENCE(); }
    }
};
__device__ __forceinline__ void head_rope(f32x4 (&v)[2][2], const f32x4 c, const f32x4 s, int fq) {
    if (fq < 2) { const f32x4 x1 = v[0][0], x2 = v[0][1]; v[0][0] = x1 * c - x2 * s; v[0][1] = x2 * c + x1 * s; }
}
__device__ __forceinline__ float head_rs(const f32x4 (&v)[2][2]) { return rsqrtf(red_fq((dot4(v[0][0]) + dot4(v[0][1])) + (dot4(v[1][0]) + dot4(v[1][1]))) * (1.f / 64.f) + EPS); }
__device__ __forceinline__ int head_dq(int bj, int n, int fq) { return bj ? 32 + 8 * fq + 4 * n : (fq < 2 ? 8 * n + 4 * fq : 8 * fq + 4 * n); }
__device__ __forceinline__ void rope_quad(const int pos, const int fodd, f32x4& c, f32x4& s) {
    const float k0[4] = {1.0f, 0.193922758102417f, 0.03760603442788124f, 0.007292665541172028f}, k1[4] = {0.0014142137952148914f, 0.00027424830477684736f, 5.3182971896603703e-05f, 1.031338433676865e-05f};
#pragma unroll
    for (int e = 0; e < 4; ++e) { const float ang = (float)pos * (fodd ? k1[e] : k0[e]); const double rev = (double)ang * 0.15915494309189535; const float fr = (float)(rev - rint(rev));
        c[e] = __builtin_amdgcn_cosf(fr); s[e] = __builtin_amdgcn_sinf(fr); }
}
__device__ __forceinline__ void head_store16(bf16_t* rowp, const f32x4 (&v)[2][2], int fq) {
    const u32x2 p00 = pack4(v[0][0]), p01 = pack4(v[0][1]);
    const u32x2 snd = fq == 0 ? p01 : p00;
    u32x2 rcv; rcv.x = (unsigned)__builtin_amdgcn_ds_swizzle((int)snd.x, 0x401F); rcv.y = (unsigned)__builtin_amdgcn_ds_swizzle((int)snd.y, 0x401F);
    u32x4 w0;
    if (fq == 0) { w0.x = p00.x; w0.y = p00.y; w0.z = rcv.x; w0.w = rcv.y; }
    else if (fq == 1) { w0.x = rcv.x; w0.y = rcv.y; w0.z = p01.x; w0.w = p01.y; }
    else { w0.x = p00.x; w0.y = p00.y; w0.z = p01.x; w0.w = p01.y; }
    *(u32x4*)(rowp + 8 * fq) = w0;
    *(u32x4*)(rowp + 32 + 8 * fq) = pack8(v[1][0], v[1][1]);
}
__device__ __forceinline__ void rope4_load(const float* ROPE, int rowbase, int fq, f32x4 (&c)[4], f32x4 (&s)[4]) {
    const int fo = 4 * (fq & 1);
#pragma unroll
    for (int m = 0; m < 4; ++m) { const float* rp = ROPE + (size_t)(rowbase + 16 * m) * 16 + fo; c[m] = *(const f32x4*)rp; s[m] = *(const f32x4*)(rp + 8); }
}

struct EpiProj {
    Bufs B; const float* SS; const float* g_kn; const float* g_ik; const float* i_bias; const float* f_bias;
    struct Pre {}; __device__ __forceinline__ void prefetch(Pre&, const pg8::Unit&, int, int, int, int) const {}
    __device__ __forceinline__ void operator()(const Acc& acc, const pg8::Unit& u, int wr, int wc, int fr, int fq, const Pre&) const {
        asm volatile("" : "+v"(fr), "+v"(fq));
        const int pn = u.pn, row0 = u.pm * 256 + wr * 64 + fr, colw = wc * 32 + 8 * fq;
        if (pn == 0 || (pn >= 2 && pn <= 9)) {
            bf16_t* dst; int ld, cb;
            if (pn == 0) { dst = B.CQ; ld = 256; cb = 0; } else if (pn < 4) { dst = B.MQ; ld = 512; cb = (pn - 2) * 256; } else if (pn < 6) { dst = B.MK; ld = 512; cb = (pn - 4) * 256; }
            else if (pn < 8) { dst = B.MV; ld = 512; cb = (pn - 6) * 256; } else { dst = B.MO; ld = 512; cb = (pn - 8) * 256; }
            float rs8[8];
            { f32x4 s4[8];
#pragma unroll
              for (int i = 0; i < 8; ++i) s4[i] = *(const f32x4*)(SS + (size_t)(row0 + (i >> 2) * 128 + (i & 3) * 16) * 16 + 4 * fq);
#pragma unroll
              for (int i = 0; i < 8; ++i) rs8[i] = rsqrtf(red_fq((s4[i][0] + s4[i][1]) + (s4[i][2] + s4[i][3])) * (1.f / 1024.f) + EPS); }
#pragma unroll
            for (int ai = 0; ai < 2; ++ai) {
                float rs[4];
#pragma unroll
                for (int m = 0; m < 4; ++m) rs[m] = rs8[ai * 4 + m];
#pragma unroll
                for (int m = 0; m < 4; ++m) { const int row = row0 + ai * 128 + m * 16; float sq = 0.f;
#pragma unroll
                    for (int bj = 0; bj < 2; ++bj) { f32x4 a = acc[ai][bj][m][0] * rs[m], b = acc[ai][bj][m][1] * rs[m];
                        if (pn >= 8) { a = sig4(a); b = sig4(b); }
                        sq += dot4(a) + dot4(b);
                        *(u32x4*)(dst + (size_t)row * ld + cb + bj * 128 + colw) = pack8(a, b); }
                    if (pn == 0) { sq = red_fq(sq); if (fq == 0) B.CQSS[(size_t)row * 4 + wc] = sq; } }
                EPI_FENCE(); }
        } else if (pn == 1) {
            int dq[2][2];
#pragma unroll
            for (int bj = 0; bj < 2; ++bj)
#pragma unroll
                for (int n = 0; n < 2; ++n) dq[bj][n] = head_dq(bj, n, fq);
#pragma unroll
            for (int ai = 0; ai < 2; ++ai) {
#pragma unroll
                for (int mp = 0; mp < 2; ++mp) {
                    float rs2[2]; rs2_load(SS, row0 + ai * 128 + 32 * mp, fq, rs2);
                    f32x4 rc[2], rsn[2]; const int fo = 4 * (fq & 1);
                    if (wc < 2) {
#pragma unroll
                        for (int mm = 0; mm < 2; ++mm) { const float* rp = B.ROPE + (size_t)(row0 + ai * 128 + (2 * mp + mm) * 16) * 16 + fo; rc[mm] = *(const f32x4*)rp; rsn[mm] = *(const f32x4*)(rp + 8); } }
#pragma unroll
                    for (int mm = 0; mm < 2; ++mm) { const int m = 2 * mp + mm, row = row0 + ai * 128 + m * 16;
                        f32x4 v[2][2];
#pragma unroll
                        for (int bj = 0; bj < 2; ++bj)
#pragma unroll
                            for (int n = 0; n < 2; ++n) v[bj][n] = acc[ai][bj][m][n] * rs2[mm];
                        if (wc < 2) {
                            const float hr = head_rs(v);
#pragma unroll
                            for (int bj = 0; bj < 2; ++bj)
#pragma unroll
                                for (int n = 0; n < 2; ++n) v[bj][n] = v[bj][n] * hr * *(const f32x4*)(g_kn + dq[bj][n]);
                            head_rope(v, rc[mm], rsn[mm], fq);
                            head_store16(B.K + (size_t)row * 128 + wc * 64, v, fq);
                        } else {
                            const int tk = row & (SEQ - 1), tkp = (tk & ~12) | ((tk & 4) << 1) | ((tk & 8) >> 1);
                            const unsigned vo = (unsigned)(((row >> 11) * 2 + (wc - 2)) * 64 * SEQ + tkp);
#pragma unroll
                            for (int bj = 0; bj < 2; ++bj)
#pragma unroll
                                for (int n = 0; n < 2; ++n)
#pragma unroll
                                    for (int j = 0; j < 4; ++j) B.VT[vo + (unsigned)((dq[bj][n] + j) * SEQ)] = f2bf(v[bj][n][j]);
                        } }
                    EPI_FENCE(); } }
        } else {
            if (wc == 0) {
                int dq[2][2];
#pragma unroll
                for (int bj = 0; bj < 2; ++bj)
#pragma unroll
                    for (int n = 0; n < 2; ++n) dq[bj][n] = head_dq(bj, n, fq);
#pragma unroll
                for (int ai = 0; ai < 2; ++ai) {
#pragma unroll
                    for (int mp = 0; mp < 2; ++mp) {
                        float rs2[2]; rs2_load(SS, row0 + ai * 128 + 32 * mp, fq, rs2);
                        f32x4 rc[2], rsn[2]; const int fo = 4 * (fq & 1);
#pragma unroll
                        for (int mm = 0; mm < 2; ++mm) { const float* rp = B.ROPE + (size_t)(row0 + ai * 128 + (2 * mp + mm) * 16) * 16 + fo; rc[mm] = *(const f32x4*)rp; rsn[mm] = *(const f32x4*)(rp + 8); }
#pragma unroll
                        for (int mm = 0; mm < 2; ++mm) { const int m = 2 * mp + mm, row = row0 + ai * 128 + m * 16;
                            f32x4 v[2][2];
#pragma unroll
                            for (int bj = 0; bj < 2; ++bj)
#pragma unroll
                                for (int n = 0; n < 2; ++n) v[bj][n] = acc[ai][bj][m][n] * rs2[mm];
                            const float hr = head_rs(v);
#pragma unroll
                            for (int bj = 0; bj < 2; ++bj)
#pragma unroll
                                for (int n = 0; n < 2; ++n) v[bj][n] = v[bj][n] * hr * *(const f32x4*)(g_ik + dq[bj][n]);
                            head_rope(v, rc[mm], rsn[mm], fq);
                            head_store16(B.IK + (size_t)row * 64, v, fq); }
                        EPI_FENCE(); } }
            } else if (wc == 1) {
                const f32x4 ib = *(const f32x4*)i_bias, fb = *(const f32x4*)f_bias;
#pragma unroll
                for (int ai = 0; ai < 2; ++ai) {
                    float rs[4]; rs4_load(SS, row0 + ai * 128, fq, rs);
#pragma unroll
                    for (int m = 0; m < 4; ++m) { const int row = row0 + ai * 128 + m * 16;
                        const f32x4 a = acc[ai][0][m][0] * rs[m], b = acc[ai][0][m][1] * rs[m];
                        if (fq == 0) { *(f32x4*)(B.IW + (size_t)row * 8) = a * IDX_SCALE; *(f32x4*)(B.IW + (size_t)row * 8 + 4) = b * IDX_SCALE; }
                        else if (fq == 1) { *(f32x4*)(B.MI + (size_t)row * 4) = a + ib; f32x4 t = b + fb, o;
#pragma unroll
                            for (int j = 0; j < 4; ++j) o[j] = logsigmoidf_(t[j]);
                            *(f32x4*)(B.MF + (size_t)row * 4) = o; } }
                    EPI_FENCE(); }
            }
        }
    }
};
struct EpiQup {
    Bufs B; const float* g_qn; const int* pos;
    struct Pre {}; __device__ __forceinline__ void prefetch(Pre&, const pg8::Unit&, int, int, int, int) const {}
    __device__ __forceinline__ void operator()(const Acc& acc, const pg8::Unit& u, int wr, int wc, int fr, int fq, const Pre&) const {
        asm volatile("" : "+v"(fr), "+v"(fq));
        const int pn = u.pn, row0 = u.pm * 256 + wr * 64 + fr;
        int dq[2][2];
#pragma unroll
        for (int bj = 0; bj < 2; ++bj)
#pragma unroll
            for (int n = 0; n < 2; ++n) dq[bj][n] = head_dq(bj, n, fq);
        bf16_t* dst = (pn < 2 ? B.Q : B.IQ) + ((pn & 1) * 4 + wc) * 64;
        int pr[8]; float cp[8];
#pragma unroll
        for (int i = 0; i < 8; ++i) { const int row = row0 + (i >> 2) * 128 + (i & 3) * 16; pr[i] = pos[row]; cp[i] = B.CQSS[(size_t)row * 4 + fq]; }
        f32x4 gq[2][2];
#pragma unroll
        for (int bj = 0; bj < 2; ++bj)
#pragma unroll
            for (int n = 0; n < 2; ++n) gq[bj][n] = pn < 2 ? *(const f32x4*)(g_qn + dq[bj][n]) : (f32x4){1.f, 1.f, 1.f, 1.f};
#pragma unroll
        for (int ai = 0; ai < 2; ++ai)
#pragma unroll
            for (int m = 0; m < 4; ++m) { const int i = ai * 4 + m, row = row0 + ai * 128 + m * 16;
                const float rs = rsqrtf(red_fq(cp[i]) * (1.f / 256.f) + EPS);
                f32x4 rc, rsn; rope_quad(pr[i], fq & 1, rc, rsn);
                f32x4 v[2][2];
#pragma unroll
                for (int bj = 0; bj < 2; ++bj)
#pragma unroll
                    for (int n = 0; n < 2; ++n) v[bj][n] = acc[ai][bj][m][n] * rs;
                if (pn < 2) { const float hr = head_rs(v) * QSCALE;
#pragma unroll
                    for (int bj = 0; bj < 2; ++bj)
#pragma unroll
                        for (int n = 0; n < 2; ++n) v[bj][n] = v[bj][n] * hr * gq[bj][n]; }
                head_rope(v, rc, rsn, fq);
                head_store16(dst + (size_t)row * 512, v, fq); }
    }
};

__device__ __forceinline__ int proj_src_col(int n) {
    const int tile = n >> 8, p = n & 255, wc = (p >> 5) & 3, bj = p >> 7, q = p & 31, d = dimmap(bj * 32 + q);
    switch (tile) {
        case 0: return C_CQ + p;
        case 1: return wc < 2 ? C_AK + wc * 64 + d : C_AV + (wc - 2) * 64 + d;
        case 2: case 3: return C_MQ + (tile - 2) * 256 + p;
        case 4: case 5: return C_MK + (tile - 4) * 256 + p;
        case 6: case 7: return C_MV + (tile - 6) * 256 + p;
        case 8: case 9: return C_MO + (tile - 8) * 256 + p;
        default:
            if (wc == 0) return C_IK + d;
            if (wc == 1 && bj == 0) { if (q < 8) return C_IW + q; if (q < 12) return C_MI + q - 8; if (q < 16) return C_MF + q - 12; }
            return -1;
    }
}
__device__ __forceinline__ void prep_item(const float* W, int ldw, int c4, const float* g, bf16_t* Bt, int K, int n0, int k0, LAS float* scr, int lane) {
    f32x4 v[8];
#pragma unroll
    for (int i = 0; i < 8; ++i) { const int kk = 8 * i + (lane >> 3); v[i] = c4 >= 0 ? *(const f32x4*)(W + (size_t)(k0 + kk) * ldw + c4) : (f32x4){0.f, 0.f, 0.f, 0.f}; }
#pragma unroll
    for (int i = 0; i < 8; ++i) { const int kk = 8 * i + (lane >> 3); const float gs = g ? g[k0 + kk] : 1.f; LAS float* d = scr + kk * 33 + 4 * (lane & 7);
        d[0] = v[i][0] * gs; d[1] = v[i][1] * gs; d[2] = v[i][2] * gs; d[3] = v[i][3] * gs; }
    asm volatile("s_waitcnt lgkmcnt(0)" ::: "memory");
    const int cc = lane & 7;
#pragma unroll
    for (int j = 0; j < 4; ++j) { const int n = (lane >> 3) + 8 * j; const LAS float* s = scr + (8 * cc) * 33 + n;
        u32x4 o; o.x = cvt_pk_bf16(s[0 * 33], s[1 * 33]); o.y = cvt_pk_bf16(s[2 * 33], s[3 * 33]); o.z = cvt_pk_bf16(s[4 * 33], s[5 * 33]); o.w = cvt_pk_bf16(s[6 * 33], s[7 * 33]);
        *(u32x4*)(Bt + (size_t)(n0 + n) * K + k0 + 8 * cc) = o; }
    asm volatile("s_waitcnt lgkmcnt(0)" ::: "memory");
}

struct Args {
    const float* in[24]; float* out; unsigned char* ws; int ph_lo, ph_hi, bar_slot, pad;
};

__device__ __forceinline__ void phase_prologue(const Args& a, const Bufs& B, LAS unsigned char* lds, int gw, int NGW, int wave, int lane) {
    LAS float* scr = (LAS float*)(lds + wave * 8704);
    constexpr int I_IN = (DM / 64) * (NPROJ / 32), I_QUP = (QR / 64) * (1024 / 32), I_OUT = (DM / 64) * (DM / 32), I_F1 = (DM / 64) * (DFF / 32), I_F2 = (DFF / 64) * (DM / 32), I_G = I_OUT, I_P = (PLE / 64) * (DM / 32);
    constexpr int I_LAYER = I_IN + I_QUP + I_OUT + I_F1 + I_F2 + I_G + I_P;
    for (int it = gw; it < DEPTH * I_LAYER; it += NGW) {
        const int l = it / I_LAYER; int r = it % I_LAYER;
        unsigned char* wb = a.ws + WS_W + (size_t)l * W_LSTRIDE;
        const int lane31 = 4 * (lane & 7);
        if (r < I_IN) { const int nblk = NPROJ / 32, kb = r / nblk, nb = r % nblk; prep_item(a.in[4] + (size_t)l * DM * IN_W, IN_W, proj_src_col(nb * 32 + lane31), a.in[3] + l * DM, (bf16_t*)(wb + WO_IN), DM, nb * 32, kb * 64, scr, lane); continue; } r -= I_IN;
        if (r < I_QUP) { const int nblk = 32, kb = r / nblk, nb = r % nblk; const int n = nb * 32 + lane31, tile = n >> 8, p = n & 255, wc = (p >> 5) & 3, d = dimmap((p >> 7) * 32 + (p & 31));
            const float* W = (tile < 2 ? a.in[6] : a.in[7]) + (size_t)l * QR * 512;
            prep_item(W, 512, ((tile & 1) * 4 + wc) * 64 + d, a.in[5] + l * QR, (bf16_t*)(wb + WO_QUP), QR, nb * 32, kb * 64, scr, lane); continue; } r -= I_QUP;
        if (r < I_OUT) { const int nblk = DM / 32, kb = r / nblk, nb = r % nblk; prep_item(a.in[16] + (size_t)l * DM * DM, DM, nb * 32 + lane31, nullptr, (bf16_t*)(wb + WO_OUT), DM, nb * 32, kb * 64, scr, lane); continue; } r -= I_OUT;
        if (r < I_F1) { const int nblk = DFF / 32, kb = r / nblk, nb = r % nblk; prep_item(a.in[18] + (size_t)l * DM * DFF, DFF, nb * 32 + lane31, a.in[17] + l * DM, (bf16_t*)(wb + WO_F1), DM, nb * 32, kb * 64, scr, lane); continue; } r -= I_F1;
        if (r < I_F2) { const int nblk = DM / 32, kb = r / nblk, nb = r % nblk; prep_item(a.in[19] + (size_t)l * DFF * DM, DM, nb * 32 + lane31, nullptr, (bf16_t*)(wb + WO_F2), DFF, nb * 32, kb * 64, scr, lane); continue; } r -= I_F2;
        if (r < I_G) { const int nblk = DM / 32, kb = r / nblk, nb = r % nblk; prep_item(a.in[21] + (size_t)l * DM * DM, DM, nb * 32 + lane31, a.in[20] + l * DM, (bf16_t*)(wb + WO_G), DM, nb * 32, kb * 64, scr, lane); continue; } r -= I_G;
        { const int nblk = DM / 32, kb = r / nblk, nb = r % nblk; prep_item(a.in[23] + (size_t)l * PLE * DM, DM, nb * 32 + lane31, nullptr, (bf16_t*)(wb + WO_P), PLE, nb * 32, kb * 64, scr, lane); }
    }
    const float* x = a.in[0];
    for (int row0 = gw * 4; row0 < M; row0 += NGW * 4) {
        f32x4 v[4][4];
#pragma unroll
        for (int r = 0; r < 4; ++r) { const f32x4* xr = (const f32x4*)(x + (size_t)(row0 + r) * DM) + lane;
#pragma unroll
            for (int j = 0; j < 4; ++j) v[r][j] = xr[64 * j]; }
#pragma unroll
        for (int r = 0; r < 4; ++r) { float s = 0.f; u32x2* o = (u32x2*)((bf16_t*)a.out + (size_t)(row0 + r) * DM) + lane;
#pragma unroll
            for (int j = 0; j < 4; ++j) { s += dot4(v[r][j]); o[64 * j] = pack4(v[r][j]); }
            s = wave_sum(s);
            if (lane < 16) B.SS[(size_t)(row0 + r) * 16 + lane] = lane == 0 ? s : 0.f; }
    }
    const int* pos = (const int*)a.in[2];
    for (int i = gw * 64 + lane; i < M * 8; i += NGW * 64) {
        const int row = i >> 3, f = i & 7;
        const float inv = exp2f(-(float)f * (18.931568569324174f / 8.f));
        const float ang = (float)pos[row] * inv;
        const double rev = (double)ang * 0.15915494309189535; const float fr = (float)(rev - rint(rev));
        B.ROPE[row * 16 + f] = __builtin_amdgcn_cosf(fr); B.ROPE[row * 16 + 8 + f] = __builtin_amdgcn_sinf(fr);
    }
    const f32x4* p4 = (const f32x4*)a.in[1]; u32x2* pb = (u32x2*)B.PB;
#pragma unroll 4
    for (size_t i = (size_t)gw * 64 + lane; i < (size_t)DEPTH * M * PLE / 4; i += (size_t)NGW * 64) pb[i] = pack4(p4[i]);
}

typedef float f32x16 __attribute__((ext_vector_type(16)));
__device__ __forceinline__ unsigned half_sum_u(unsigned v) {
#pragma unroll
    for (int o = 1; o < 32; o <<= 1) v += (unsigned)__shfl_xor((int)v, o);
    return v;
}
__device__ __forceinline__ unsigned half_sum_dpp(unsigned v, int hf) {
    v += (unsigned)__builtin_amdgcn_update_dpp(0, (int)v, 0xB1, 0xf, 0xf, false);
    v += (unsigned)__builtin_amdgcn_update_dpp(0, (int)v, 0x4E, 0xf, 0xf, false);
    v += (unsigned)__builtin_amdgcn_update_dpp(0, (int)v, 0x141, 0xf, 0xf, false);
    v += (unsigned)__builtin_amdgcn_update_dpp(0, (int)v, 0x140, 0xf, 0xf, false);
    const unsigned s0 = (unsigned)__builtin_amdgcn_readlane((int)v, 0), s1 = (unsigned)__builtin_amdgcn_readlane((int)v, 16), s2 = (unsigned)__builtin_amdgcn_readlane((int)v, 32), s3 = (unsigned)__builtin_amdgcn_readlane((int)v, 48);
    return hf ? s2 + s3 : s0 + s1;
}
struct IdxPre { bf16x8 af0, af1; f32x4 w; u32x4 g0[4]; };
__device__ __forceinline__ void idx_preload(IdxPre& P, const Bufs& B, int b, int qb, int wave, int lane) {
    const int hf = lane >> 5, l15 = lane & 15, q4 = lane >> 4, tid = wave * 64 + lane;
    const int q0w = qb * 16 + 2 * wave, q = q0w + hf; const size_t rowb = (size_t)b * SEQ;
    const bf16_t* aqb = B.IQ + rowb * 512; const unsigned ao = (unsigned)((q0w + (l15 >> 3)) * 512 + (l15 & 7) * 64 + 8 * q4);
    P.af0 = *(const bf16x8*)(aqb + ao); P.af1 = *(const bf16x8*)(aqb + (ao + 32u));
    P.w = *(const f32x4*)(B.IW + rowb * 8 + (unsigned)q * 8u + 4u * (unsigned)(q4 & 1));
    const bf16_t* kb = B.IK + rowb * 64;
#pragma unroll
    for (int i = 0; i < 4; ++i) P.g0[i] = *(const u32x4*)(kb + ((unsigned)tid * 8u + (unsigned)i * 4096u));
}
__device__ __forceinline__ int idx_wg_item(const Bufs& B, LAS unsigned char* lds, int b, int qb, int wave, int lane, const IdxPre& P, IdxPre& Pn, volatile LAS int* slotn, bool ldr, int nxt, int dsh, int bb) {
    { unsigned m1 = ~0u; asm volatile("" : "+s"(m1)); lane = (int)__builtin_amdgcn_mbcnt_hi(m1, __builtin_amdgcn_mbcnt_lo(m1, 0u)); }
    const int hf = lane >> 5, l31 = lane & 31, l15 = lane & 15, q4 = lane >> 4, tid = wave * 64 + lane;
    const int q0w = qb * 16 + 2 * wave;
    const int nt = ((qb * 16 + 15) >> 5) + 1, ng = (nt + 7) >> 3;
    const size_t rowb = (size_t)b * SEQ;
    const int q = q0w + hf;
    const bf16x8 af0 = P.af0, af1 = P.af1;
    float w4[4];
#pragma unroll
    for (int j = 0; j < 4; ++j) w4[j] = P.w[j];
    const bf16_t* kb = B.IK + rowb * 64;
    const int sd0 = (tid >> 3) * 128 + (((tid & 7) ^ ((tid >> 3) & 7)) << 4);
    int roff[2][2];
#pragma unroll
    for (int th = 0; th < 2; ++th)
#pragma unroll
        for (int ks = 0; ks < 2; ++ks) roff[th][ks] = (16 * th + l15) * 128 + (((4 * ks + q4) ^ (l15 & 7)) << 4);
    unsigned sc[64];
    u32x4 pre[4], nx2[4];
    unsigned go = (unsigned)tid * 8u;
    asm volatile("" : "+v"(go));
#pragma unroll
    for (int i = 0; i < 4; ++i) pre[i] = P.g0[i];
    __syncthreads();
#pragma unroll
    for (int i = 0; i < 4; ++i) *(LAS u32x4*)(lds + sd0 + i * 8192) = pre[i];
    if (ng > 1) { go += 256u * 64u; asm volatile("" : "+v"(go));
#pragma unroll
        for (int i = 0; i < 4; ++i) pre[i] = *(const u32x4*)(kb + (go + (unsigned)i * 4096u)); }
    __syncthreads();
#pragma unroll
    for (int g = 0; g < 8; ++g) {
        if (g < ng) {
            if (g + 2 < ng) {
                go += 256u * 64u; asm volatile("" : "+v"(go));
#pragma unroll
                for (int i = 0; i < 4; ++i) nx2[i] = *(const u32x4*)(kb + (go + (unsigned)i * 4096u)); }
            const LAS unsigned char* buf = lds + (g % 3) * 32768;
            bf16x8 fr[4], fn[4];
            fr[0] = *(const LAS bf16x8*)(buf + roff[0][0]); fr[1] = *(const LAS bf16x8*)(buf + roff[1][0]); fr[2] = *(const LAS bf16x8*)(buf + roff[0][1]); fr[3] = *(const LAS bf16x8*)(buf + roff[1][1]);
            float own_p = 0.f, rcv_p = 0.f;
#pragma unroll
            for (int tt = 0; tt < 8; ++tt) { const int t = g * 8 + tt;
                if (tt < 7) { fn[0] = *(const LAS bf16x8*)(buf + (tt + 1) * 4096 + roff[0][0]); fn[1] = *(const LAS bf16x8*)(buf + (tt + 1) * 4096 + roff[1][0]);
                              fn[2] = *(const LAS bf16x8*)(buf + (tt + 1) * 4096 + roff[0][1]); fn[3] = *(const LAS bf16x8*)(buf + (tt + 1) * 4096 + roff[1][1]); }
                f32x4 a0 = {0.f, 0.f, 0.f, 0.f}, a1 = {0.f, 0.f, 0.f, 0.f};
                a0 = __builtin_amdgcn_mfma_f32_16x16x32_bf16(af0, fr[0], a0, 0, 0, 0);
                a1 = __builtin_amdgcn_mfma_f32_16x16x32_bf16(af0, fr[1], a1, 0, 0, 0);
                a0 = __builtin_amdgcn_mfma_f32_16x16x32_bf16(af1, fr[2], a0, 0, 0, 0);
                a1 = __builtin_amdgcn_mfma_f32_16x16x32_bf16(af1, fr[3], a1, 0, 0, 0);
                if (tt > 0) { const float s = own_p + rcv_p; const unsigned vm = (unsigned)-(int)(((t - 1) * 32 + l31) <= q); sc[t - 1] = f2ord(s + 0.f) & vm; }
                float p0, p1;
#pragma unroll
                for (int r = 0; r < 4; ++r) {
                    const float x0 = __int_as_float(max(__float_as_int(a0[r]), 0)), x1 = __int_as_float(max(__float_as_int(a1[r]), 0));
                    if (r == 0) { asm("v_mul_f32 %0, %1, %2" : "=v"(p0) : "v"(w4[0]), "v"(x0)); asm("v_mul_f32 %0, %1, %2" : "=v"(p1) : "v"(w4[0]), "v"(x1)); }
                    else { asm("v_fma_f32 %0, %1, %2, %0" : "+v"(p0) : "v"(w4[r]), "v"(x0)); asm("v_fma_f32 %0, %1, %2, %0" : "+v"(p1) : "v"(w4[r]), "v"(x1)); } }
                const float snd = (q4 & 1) ? p0 : p1;
                rcv_p = __int_as_float(__builtin_amdgcn_ds_swizzle(__float_as_int(snd), 0x401F));
                own_p = (q4 & 1) ? p1 : p0;
#pragma unroll
                for (int i = 0; i < 4; ++i) fr[i] = fn[i];
            }
            { const int t = g * 8 + 7; const float s = own_p + rcv_p; const unsigned vm = (unsigned)-(int)((t * 32 + l31) <= q); sc[t] = f2ord(s + 0.f) & vm; }
            if (g + 1 < ng) {
#pragma unroll
                for (int i = 0; i < 4; ++i) *(LAS u32x4*)(lds + ((g + 1) % 3) * 32768 + sd0 + i * 8192) = pre[i]; }
#pragma unroll
            for (int i = 0; i < 4; ++i) pre[i] = nx2[i];
            __syncthreads();
        } else {
#pragma unroll
            for (int tt = 0; tt < 8; ++tt) sc[g * 8 + tt] = 0u;
        }
    }
    int itn;
    { if (ldr) slotn[0] = nxt; __syncthreads(); itn = __builtin_amdgcn_readfirstlane(slotn[0]); if (itn < (128 << dsh)) idx_preload(Pn, B, bb + (itn & ((1 << dsh) - 1)), 127 - (itn >> dsh), wave, lane); }
    const bool need = q + 1 > TOPK;
    unsigned Pth = 0u, r_take = 0u;
    if (__any(need)) {
        unsigned prefix = 0u, cge = 0xffffffffu, nhi = 0u; bool done = !need; int bit = 31;
#pragma unroll 1
        for (; bit >= 0; --bit) {
            if (!__any(!done && (cge - nhi > 32u))) break;
            const unsigned cand = prefix | (1u << bit);
            unsigned c0 = 0u, c1 = 0u;
#pragma unroll
            for (int t8 = 0; t8 < 8; ++t8) if (t8 < ng) {
#pragma unroll
                for (int tt = 0; tt < 8; tt += 2) { c0 += sc[t8 * 8 + tt] >= cand ? 1u : 0u; c1 += sc[t8 * 8 + tt + 1] >= cand ? 1u : 0u; } }
            const unsigned c = half_sum_dpp(c0 + c1, hf);
            if (!done) { if (c >= (unsigned)TOPK) { prefix = cand; cge = c; } else nhi = c; if (c == (unsigned)TOPK) { done = true; Pth = cand - 1u; } }
        }
        if (__any(!done)) {
            int hfl = hf; asm volatile("" : "+v"(hfl));
            LAS unsigned* lst = (LAS unsigned*)(lds + 98304) + (wave * 2 + hfl) * 32;
            const int sh = bit + 1;
            unsigned base = 0u;
#pragma unroll
            for (int t8 = 0; t8 < 8; ++t8) if (t8 < ng) {
#pragma unroll
                for (int tt = 0; tt < 8; ++tt) { const unsigned v = sc[t8 * 8 + tt];
                    const bool fl = !done && v != 0u && ((v ^ prefix) >> sh) == 0u;
                    const unsigned long long bm = __ballot(fl); const unsigned mh = hf ? (unsigned)(bm >> 32) : (unsigned)bm;
                    const unsigned pos = base + __popc(mh & ((1u << l31) - 1u));
                    if (fl && pos < 32u) lst[pos] = v;
                    base += __popc(mh); } }
            const unsigned cv = (unsigned)l31 < base ? lst[l31] : 0u;
#pragma unroll 1
            for (; bit >= 0; --bit) {
                if (__all(done)) break;
                const unsigned cand = prefix | (1u << bit);
                const unsigned long long bm = __ballot(cv >= cand); const unsigned c = nhi + __popc(hf ? (unsigned)(bm >> 32) : (unsigned)bm);
                if (!done) { if (c >= (unsigned)TOPK) prefix = cand; if (c == (unsigned)TOPK) { done = true; Pth = cand - 1u; } }
            }
            const bool tie = need && !done;
            if (__any(tie)) {
                const unsigned long long bm = __ballot(cv > prefix); const unsigned c = nhi + __popc(hf ? (unsigned)(bm >> 32) : (unsigned)bm);
                if (tie) { Pth = prefix; r_take = (unsigned)TOPK - c; }
            }
        }
    }
    const bool anytie = __any(r_take > 0u);
    unsigned taken = 0u;
    unsigned* sob = B.SEL + rowb * 64; const unsigned soo = (unsigned)q * 64u;
    int hfw = hf; asm volatile("" : "+v"(hfw));
    LAS unsigned* wl = (LAS unsigned*)(lds + 98304 + 2048) + (wave * 2 + hfw) * 64;
#pragma unroll
    for (int t = 0; t < 64; ++t) {
        unsigned wsel = 0u;
        if ((t >> 3) < ng) {
            const unsigned v = sc[t];
            bool sel = v > Pth;
            if (anytie) {
                const bool eq = (v == Pth) && (r_take > 0u);
                const unsigned long long bm = __ballot(eq); const unsigned mh = hf ? (unsigned)(bm >> 32) : (unsigned)bm;
                const unsigned below = __popc(mh & ((1u << l31) - 1u));
                sel = sel || (eq && (taken + below < r_take));
                taken += __popc(mh);
            }
            const unsigned long long sm = __ballot(sel);
            wsel = hf ? (unsigned)(sm >> 32) : (unsigned)sm;
        }
        if (l31 == 0) wl[t] = wsel;
    }
    sob[soo + (unsigned)l31] = wl[l31]; sob[soo + 32u + (unsigned)l31] = wl[32 + l31];
    return itn;
}
constexpr int AT_KB = 0, AT_VB = 49152, AT_SEL = 98304, AT_END = 114688;
__device__ __forceinline__ unsigned cvt_pk_bf16_nv(float lo, float hi) { unsigned r; asm("v_cvt_pk_bf16_f32 %0, %1, %2" : "=v"(r) : "v"(lo), "v"(hi)); return r; }
template <int G, bool HAS_QK, bool HAS_PV>
__device__ __forceinline__ void att_group(f32x16& Sc, const unsigned mw, float& ps, unsigned (&w)[8], f32x16& Sn, const bf16x8 (&kfn)[4], const bf16x8 (&qfn)[4],
                                          f32x16 (&oa)[2], const bf16x8 (&vf)[2][2], const bf16x8 (&pbp)[2]) {
    if constexpr (HAS_QK && G < 4) {
        if constexpr (G == 0) { const f32x16 z = {0.f, 0.f, 0.f, 0.f, 0.f, 0.f, 0.f, 0.f, 0.f, 0.f, 0.f, 0.f, 0.f, 0.f, 0.f, 0.f}; Sn = __builtin_amdgcn_mfma_f32_32x32x16_bf16(kfn[0], qfn[0], z, 0, 0, 0); }
        else Sn = __builtin_amdgcn_mfma_f32_32x32x16_bf16(kfn[G], qfn[G], Sn, 0, 0, 0);
        asm volatile("" : "+v"(Sn));
    }
    if constexpr (HAS_PV && G >= 4) { oa[(G - 4) >> 1] = __builtin_amdgcn_mfma_f32_32x32x16_bf16(vf[(G - 4) >> 1][(G - 4) & 1], pbp[(G - 4) & 1], oa[(G - 4) >> 1], 0, 0, 0);
        asm volatile("" : "+v"(oa[(G - 4) >> 1])); }
    constexpr int R = 2 * G;
    asm volatile("" : "+v"(Sc));
    float x0 = Sc[R], x1 = Sc[R + 1];
    const float e0 = __builtin_amdgcn_exp2f(x0), e1 = __builtin_amdgcn_exp2f(x1); int m0, m1;
    asm("v_bfe_i32 %0, %1, %2, 1" : "=v"(m0) : "v"(mw), "n"((R & 3) + 8 * (R >> 2)));
    asm("v_bfe_i32 %0, %1, %2, 1" : "=v"(m1) : "v"(mw), "n"(((R + 1) & 3) + 8 * ((R + 1) >> 2)));
    const float p0 = __int_as_float(__float_as_int(e0) & m0), p1 = __int_as_float(__float_as_int(e1) & m1);
    ps += p0 + p1; asm volatile("" : "+v"(ps));
    w[G] = cvt_pk_bf16_nv(p0, p1);
    __builtin_amdgcn_sched_barrier(0);
}
template <bool HAS_QK, bool HAS_PV>
__device__ __forceinline__ void att_step(f32x16& Sc, const unsigned mw, float& lsum, bf16x8 (&pbo)[2], f32x16& Sn, const bf16x8 (&kfn)[4], const bf16x8 (&qfn)[4],
                                         f32x16 (&oa)[2], const bf16x8 (&vf)[2][2], const bf16x8 (&pbp)[2]) {
    unsigned w[8]; float ps = 0.f;
    __builtin_amdgcn_sched_barrier(0);
    att_group<0, HAS_QK, HAS_PV>(Sc, mw, ps, w, Sn, kfn, qfn, oa, vf, pbp); att_group<1, HAS_QK, HAS_PV>(Sc, mw, ps, w, Sn, kfn, qfn, oa, vf, pbp);
    att_group<2, HAS_QK, HAS_PV>(Sc, mw, ps, w, Sn, kfn, qfn, oa, vf, pbp); att_group<3, HAS_QK, HAS_PV>(Sc, mw, ps, w, Sn, kfn, qfn, oa, vf, pbp);
    att_group<4, HAS_QK, HAS_PV>(Sc, mw, ps, w, Sn, kfn, qfn, oa, vf, pbp); att_group<5, HAS_QK, HAS_PV>(Sc, mw, ps, w, Sn, kfn, qfn, oa, vf, pbp);
    att_group<6, HAS_QK, HAS_PV>(Sc, mw, ps, w, Sn, kfn, qfn, oa, vf, pbp); att_group<7, HAS_QK, HAS_PV>(Sc, mw, ps, w, Sn, kfn, qfn, oa, vf, pbp);
    lsum += ps;
    u32x4 x0, x1; x0.x = w[0]; x0.y = w[1]; x0.z = w[2]; x0.w = w[3]; x1.x = w[4]; x1.y = w[5]; x1.z = w[6]; x1.w = w[7];
    pbo[0] = __builtin_bit_cast(bf16x8, x0); pbo[1] = __builtin_bit_cast(bf16x8, x1);
}
__device__ __forceinline__ void att_wg_item(const Bufs& B, LAS unsigned char* lds, int b, int qb, int wave, int lane) {
    { unsigned m1 = ~0u; asm volatile("" : "+s"(m1)); lane = (int)__builtin_amdgcn_mbcnt_hi(m1, __builtin_amdgcn_mbcnt_lo(m1, 0u)); }
    const int hf = lane >> 5, l31 = lane & 31, tid = wave * 64 + lane, wv = __builtin_amdgcn_readfirstlane(wave);
    const int g = wave & 1, q0 = qb * 64, qa = q0 + 16 * (wave >> 1);
    const int ns = qb + 1;
    const size_t rowb = (size_t)b * SEQ;
    const bf16_t* kbase = B.K + rowb * 128; const bf16_t* vbase = B.VT + (size_t)b * 128 * SEQ;
    unsigned ksrc[2], vsrc[2];
#pragma unroll
    for (int i = 0; i < 2; ++i) { const int p = tid + 512 * i;
        { const int row = p >> 4, ss = p & 15; ksrc[i] = (unsigned)(row * 256 + ((ss ^ (row & 7)) << 4)); }
        { const int row = p >> 3, ss = p & 7; vsrc[i] = (unsigned)(row * (SEQ * 2) + ((ss ^ ((row >> 1) & 7)) << 4)); } }
#define ATT_DMA(slot_, ko_, vo_) do { _Pragma("unroll") for (int _i = 0; _i < 2; ++_i) { \
        __builtin_amdgcn_global_load_lds((const unsigned*)(((const char*)kbase + (ko_)) + ksrc[_i]), (LAS unsigned*)(lds + AT_KB + (slot_) * 16384 + _i * 8192 + wv * 1024), 16, 0, 0); \
        __builtin_amdgcn_global_load_lds((const unsigned*)(((const char*)vbase + (vo_)) + vsrc[_i]), (LAS unsigned*)(lds + AT_VB + (slot_) * 16384 + _i * 8192 + wv * 1024), 16, 0, 0); } } while (0)
    __syncthreads();
    ATT_DMA(0, 0u, 0u);
    if (ns > 1) ATT_DMA(1, 64u * 256u, 128u);
    { const unsigned* sb = B.SEL + (rowb + q0) * 64;
#pragma unroll
      for (int i = 0; i < 2; ++i) *(LAS u32x4*)(lds + AT_SEL + (tid + 512 * i) * 16) = *(const u32x4*)(sb + (tid + 512 * i) * 4); }
    bf16x8 qf[2][4];
    { const bf16_t* qbase = B.Q + rowb * 512;
#pragma unroll
      for (int c2 = 0; c2 < 2; ++c2) { const unsigned qo = (unsigned)((qa + 8 * c2 + (l31 >> 2)) * 512 + (4 * g + (l31 & 3)) * 64 + 8 * hf);
#pragma unroll
        for (int ks = 0; ks < 4; ++ks) qf[c2][ks] = *(const bf16x8*)(qbase + (qo + 16u * ks)); } }
    f32x16 o[2][2]; float lsum[2] = {0.f, 0.f};
#pragma unroll
    for (int c2 = 0; c2 < 2; ++c2)
#pragma unroll
        for (int dt = 0; dt < 2; ++dt)
#pragma unroll
            for (int r = 0; r < 16; ++r) o[c2][dt][r] = 0.f;
    unsigned koff = 64u * 256u, voff = 128u;
    if (ns > 1) asm volatile("s_waitcnt vmcnt(4)" ::: "memory"); else asm volatile("s_waitcnt vmcnt(0)" ::: "memory");
    __syncthreads();
    int kro[4];
#pragma unroll
    for (int ks = 0; ks < 4; ++ks) kro[ks] = l31 * 256 + (((g * 8 + 2 * ks + hf) ^ (l31 & 7)) << 4);
    const int selo = AT_SEL + ((16 * (wave >> 1) + (l31 >> 2)) * 64) * 4;
    int cur = 0;
#pragma unroll 1
    for (int st = 0; st < ns; ++st) {
        const int nx2 = cur == 0 ? 2 : cur - 1;
        if (st + 2 < ns) { koff += 64u * 256u; voff += 128u; asm volatile("" : "+s"(koff), "+s"(voff)); ATT_DMA(nx2, koff, voff); }
        const LAS unsigned char* kb = lds + AT_KB + cur * 16384; const LAS unsigned char* vb = lds + AT_VB + cur * 16384;
        {
            bf16x8 kf0[4], kf1[4], vfa[2][2], vfb[2][2], pbA[2], pbB[2]; f32x16 Sa, Sb;
#pragma unroll
            for (int ks = 0; ks < 4; ++ks) kf0[ks] = *(const LAS bf16x8*)(kb + kro[ks]);
            const LAS unsigned* swp = (const LAS unsigned*)(lds + selo + st * 8);
            const unsigned mw00 = swp[0] >> (4 * hf), mw10 = swp[1] >> (4 * hf), mw01 = swp[8 * 64] >> (4 * hf), mw11 = swp[8 * 64 + 1] >> (4 * hf);
            { const f32x16 z = {0.f, 0.f, 0.f, 0.f, 0.f, 0.f, 0.f, 0.f, 0.f, 0.f, 0.f, 0.f, 0.f, 0.f, 0.f, 0.f};
              Sa = __builtin_amdgcn_mfma_f32_32x32x16_bf16(kf0[0], qf[0][0], z, 0, 0, 0);
#pragma unroll
              for (int ks = 1; ks < 4; ++ks) Sa = __builtin_amdgcn_mfma_f32_32x32x16_bf16(kf0[ks], qf[0][ks], Sa, 0, 0, 0); }
#pragma unroll
            for (int ks = 0; ks < 4; ++ks) kf1[ks] = *(const LAS bf16x8*)(kb + 8192 + kro[ks]);
            att_step<true, false>(Sa, mw00, lsum[0], pbA, Sb, kf0, qf[1], o[0], vfa, pbA);
#pragma unroll
            for (int dt = 0; dt < 2; ++dt) { const int row = g * 64 + 32 * dt + l31; const LAS unsigned char* vr = vb + row * 128; const int sw = (row >> 1) & 7;
#pragma unroll
                for (int s = 0; s < 2; ++s) vfa[dt][s] = *(const LAS bf16x8*)(vr + (((2 * s + hf) ^ sw) << 4)); }
            att_step<true, true>(Sb, mw01, lsum[1], pbB, Sa, kf1, qf[0], o[0], vfa, pbA);
            att_step<true, true>(Sa, mw10, lsum[0], pbA, Sb, kf1, qf[1], o[1], vfa, pbB);
#pragma unroll
            for (int dt = 0; dt < 2; ++dt) { const int row = g * 64 + 32 * dt + l31; const LAS unsigned char* vr = vb + row * 128; const int sw = (row >> 1) & 7;
#pragma unroll
                for (int s = 0; s < 2; ++s) vfb[dt][s] = *(const LAS bf16x8*)(vr + (((4 + 2 * s + hf) ^ sw) << 4)); }
            att_step<false, true>(Sb, mw11, lsum[1], pbB, Sa, kf1, qf[1], o[0], vfb, pbA);
#pragma unroll
            for (int dt = 0; dt < 2; ++dt)
#pragma unroll
                for (int s = 0; s < 2; ++s) o[1][dt] = __builtin_amdgcn_mfma_f32_32x32x16_bf16(vfb[dt][s], pbB[s], o[1][dt], 0, 0, 0);
        }
        if (st + 2 < ns) asm volatile("s_waitcnt vmcnt(4)" ::: "memory"); else asm volatile("s_waitcnt vmcnt(0)" ::: "memory");
        asm volatile("s_waitcnt lgkmcnt(0)" ::: "memory");
        __builtin_amdgcn_s_barrier();
        cur = cur == 2 ? 0 : cur + 1;
    }
#undef ATT_DMA
    { unsigned m1 = ~0u; asm volatile("" : "+s"(m1)); const int ln = (int)__builtin_amdgcn_mbcnt_hi(m1, __builtin_amdgcn_mbcnt_lo(m1, 0u));
      bf16_t* ob = B.MIX + rowb * 1024;
#pragma unroll
      for (int c2 = 0; c2 < 2; ++c2) {
        const float l = lsum[c2] + __int_as_float(__builtin_amdgcn_ds_bpermute((ln ^ 32) << 2, __float_as_int(lsum[c2]))); const float inv = __builtin_amdgcn_rcpf(l);
        const unsigned oo = (unsigned)((qa + 8 * c2 + ((ln & 31) >> 2)) * 1024 + (4 * g + (ln & 3)) * 64 + 4 * (ln >> 5));
#pragma unroll
        for (int dt = 0; dt < 2; ++dt)
#pragma unroll
            for (int rr = 0; rr < 4; ++rr) { f32x4 v; v[0] = o[c2][dt][4 * rr] * inv; v[1] = o[c2][dt][4 * rr + 1] * inv; v[2] = o[c2][dt][4 * rr + 2] * inv; v[3] = o[c2][dt][4 * rr + 3] * inv;
                *(u32x2*)(ob + (oo + (unsigned)(32 * dt + 8 * rr))) = pack4(v); }
      } }
}

#define XB_TMO      128
#define XB_XCNT(j)  (256  + 64 * (j))
#define XB_XSUB(j)  (1280 + 64 * (j))
#define XB_XGEN(j)  (2304 + 64 * (j))
#define XB_TOP      3328
#define XB_TOPGEN   3392
#define XCD_BAR_WORDS 3456
#define XB_SPIN_CAP (1u << 22)
__device__ __forceinline__ unsigned xb_ld(unsigned* p)              { return __hip_atomic_load(p, __ATOMIC_RELAXED, __HIP_MEMORY_SCOPE_AGENT); }
__device__ __forceinline__ unsigned xb_add(unsigned* p, unsigned v) { return __hip_atomic_fetch_add(p, v, __ATOMIC_RELAXED, __HIP_MEMORY_SCOPE_AGENT); }
__device__ __forceinline__ unsigned xb_xcc_id() { return (unsigned)__builtin_amdgcn_s_getreg((3 << 11) | 20) & 0xFu; }
#define XB_SPIN(cond, bar) do { unsigned _sp = 0; while (cond) { __builtin_amdgcn_s_sleep(1); \
    if ((++_sp & 255u) == 0u) { if (xb_ld(&(bar)[XB_TMO])) break; if (_sp > XB_SPIN_CAP) { atomicAdd(&(bar)[XB_TMO], 1u); break; } } } } while (0)
struct XcdBarrier { unsigned* bar; unsigned x; volatile LAS unsigned* st; };
__device__ __forceinline__ XcdBarrier xcd_barrier_post(unsigned* bar, volatile LAS unsigned* st, bool leader) {
    XcdBarrier b; b.bar = bar; b.x = xb_xcc_id(); b.st = st;
    if (leader) (void)xb_add(&bar[XB_XCNT(b.x)], 1u);
    return b;
}
__device__ __forceinline__ void xcd_barrier_complete(unsigned* bar, unsigned x, unsigned& nloc, unsigned& nx) {
    const unsigned G = gridDim.x;
    unsigned sum, cnt, mine, sp = 0u;
    for (;;) {
        sum = 0u; cnt = 0u; mine = 0u;
#pragma unroll
        for (unsigned j = 0; j < 16; ++j) { const unsigned c = xb_ld(&bar[XB_XCNT(j)]); sum += c; cnt += (c > 0u) ? 1u : 0u; mine = (j == x) ? c : mine; }
        if (sum == G) break;
        __builtin_amdgcn_s_sleep(1);
        if ((++sp & 255u) == 0u) { if (xb_ld(&bar[XB_TMO])) break; if (sp > XB_SPIN_CAP) { atomicAdd(&bar[XB_TMO], 1u); break; } }
    }
    nloc = mine > 0u ? mine : 1u; nx = cnt > 0u ? cnt : 1u;
}
__device__ __forceinline__ void xcd_barrier(const XcdBarrier& b, bool leader) {
    asm volatile("s_waitcnt vmcnt(0)" ::: "memory");
    __syncthreads();
    if (leader) {
        unsigned* bar = b.bar;
        __builtin_amdgcn_s_waitcnt(0);
        unsigned nloc = b.st[0], nx = b.st[1];
        if (nloc == 0u) { xcd_barrier_complete(bar, b.x, nloc, nx); b.st[0] = nloc; b.st[1] = nx; }
        const unsigned old = xb_add(&bar[XB_XSUB(b.x)], 1u);
        const unsigned gen = old / nloc;
        if (old + 1u == (gen + 1u) * nloc) {
            __builtin_amdgcn_fence(__ATOMIC_RELEASE, "agent");
            asm volatile("s_waitcnt vmcnt(0)" ::: "memory");
            const unsigned og = xb_add(&bar[XB_TOP], 1u);
            const unsigned tg = og / nx;
            if (og + 1u == (tg + 1u) * nx) xb_add(&bar[XB_TOPGEN], 1u);
            else XB_SPIN(xb_ld(&bar[XB_TOPGEN]) == tg, bar);
            __builtin_amdgcn_fence(__ATOMIC_ACQUIRE, "agent");
            xb_add(&bar[XB_XGEN(b.x)], 1u);
            asm volatile("s_waitcnt vmcnt(0)" ::: "memory");
        } else {
            XB_SPIN(xb_ld(&bar[XB_XGEN(b.x)]) == gen, bar);
            __builtin_amdgcn_fence(__ATOMIC_ACQUIRE, "agent");
            asm volatile("s_waitcnt vmcnt(0)" ::: "memory");
        }
    }
    __syncthreads();
}
constexpr int GB_CNT = 230000, GB_XID = 231000;
constexpr int GW_CNT0 = 232000;
__device__ __forceinline__ void grp_barrier(unsigned* ctl, const XcdBarrier& bar, const unsigned mode, const unsigned gen, bool leader, const int arrive = -1, const int wait = -1) {
    asm volatile("s_waitcnt vmcnt(0)" ::: "memory");
    __syncthreads();
    if (leader) {
        unsigned* cnt = ctl + GB_CNT + 64 * (blockIdx.x & 7);
        if (!(mode & 2u)) { __builtin_amdgcn_fence(__ATOMIC_RELEASE, "agent"); asm volatile("s_waitcnt vmcnt(0)" ::: "memory"); }
        __builtin_amdgcn_s_waitcnt(0);
        if (arrive >= 0) (void)xb_add(ctl + GW_CNT0 + 64 * arrive, 1u);
        (void)xb_add(cnt, 1u);
        const unsigned target = 32u * gen;
        XB_SPIN(xb_ld(cnt) < target, bar.bar);
        if (wait >= 0) { unsigned* wc = ctl + GW_CNT0 + 64 * wait; XB_SPIN(xb_ld(wc) < gridDim.x, bar.bar); }
        __builtin_amdgcn_fence(__ATOMIC_ACQUIRE, "agent");
        asm volatile("s_waitcnt vmcnt(0)" ::: "memory");
    }
    __syncthreads();
}

typedef float f32x4v __attribute__((ext_vector_type(4)));
constexpr int ML_QS = 0, ML_KS = 17408, ML_KGT = 34816, ML_VT = 53248, ML_PS = 71680, ML_A = 80896, ML_PM = 89088, ML_BC = 97280, ML_N = 105472, ML_DEN = 105984, ML_SCAN = 106240, ML_END = 106496;
constexpr int ML_HS = 106496;
constexpr int ML_GM = 145408;
constexpr int ML_CW = 140288;
constexpr int ML_QLD = 136, ML_TLD = 72, ML_HLD = 132;
__device__ __forceinline__ int tsw(int row, int s) { return row * ML_TLD + ((((s >> 3) ^ (row >> 3)) & 7) << 3) + (s & 7); }
__device__ __forceinline__ float wave_scan_add(float v, int lane) {
#pragma unroll
    for (int o = 1; o < 64; o <<= 1) { const float u = __shfl_up(v, o); if (lane >= o) v += u; }
    return v;
}
__device__ __forceinline__ float wave_scan_max(float v, int lane) {
#pragma unroll
    for (int o = 1; o < 64; o <<= 1) { const float u = __shfl_up(v, o); if (lane >= o) v = fmaxf(v, u); }
    return v;
}
__device__ __forceinline__ void bf8_to_f32(const u32x4 r, float (&x)[8]) {
    x[0] = __uint_as_float(r.x << 16); x[1] = __uint_as_float(r.x & 0xffff0000u); x[2] = __uint_as_float(r.y << 16); x[3] = __uint_as_float(r.y & 0xffff0000u);
    x[4] = __uint_as_float(r.z << 16); x[5] = __uint_as_float(r.z & 0xffff0000u); x[6] = __uint_as_float(r.w << 16); x[7] = __uint_as_float(r.w & 0xffff0000u);
}
__device__ __forceinline__ void mlstm_item(const Bufs& B, LAS unsigned char* lds, const int b, const int h, const int wave, const int lane, const float* g_mh, const float* conv_w, const float* conv_b) {
    const int tid = wave * 64 + lane;
    const size_t rowb = (size_t)b * SEQ;
    LAS float* As = (LAS float*)(lds + ML_A); LAS float* Pms = (LAS float*)(lds + ML_PM); LAS float* Bcs = (LAS float*)(lds + ML_BC);
    LAS float* Ns = (LAS float*)(lds + ML_N); LAS float* Dens = (LAS float*)(lds + ML_DEN); LAS float* Scan = (LAS float*)(lds + ML_SCAN);
    LAS bf16_t* Qs = (LAS bf16_t*)(lds + ML_QS); LAS bf16_t* Ks = (LAS bf16_t*)(lds + ML_KS); LAS bf16_t* KgT = (LAS bf16_t*)(lds + ML_KGT);
    LAS bf16_t* VT = (LAS bf16_t*)(lds + ML_VT); LAS bf16_t* Ps = (LAS bf16_t*)(lds + ML_PS); LAS float* Hs = (LAS float*)(lds + ML_HS);
    __syncthreads();
    {
        float lf[4], li[4];
#pragma unroll
        for (int i = 0; i < 4; ++i) { lf[i] = B.MF[(rowb + 4 * tid + i) * 4 + h]; li[i] = B.MI[(rowb + 4 * tid + i) * 4 + h]; }
        float c[4]; c[0] = lf[0]; c[1] = c[0] + lf[1]; c[2] = c[1] + lf[2]; c[3] = c[2] + lf[3];
        const float inc = wave_scan_add(c[3], lane);
        if (lane == 63) Scan[wave] = inc;
        __syncthreads();
        float off = inc - c[3];
        for (int w = 0; w < wave; ++w) off += Scan[w];
        float av[4], mx[4];
#pragma unroll
        for (int i = 0; i < 4; ++i) { const float bc = off + c[i]; Bcs[4 * tid + i] = bc; av[i] = li[i] - bc; As[4 * tid + i] = av[i]; }
        mx[0] = av[0]; mx[1] = fmaxf(mx[0], av[1]); mx[2] = fmaxf(mx[1], av[2]); mx[3] = fmaxf(mx[2], av[3]);
        const float incm = wave_scan_max(mx[3], lane);
        __syncthreads();
        if (lane == 63) Scan[wave] = incm;
        __syncthreads();
        float pre = __shfl_up(incm, 1); if (lane == 0) pre = 0.f;
        for (int w = 0; w < wave; ++w) pre = fmaxf(pre, Scan[w]);
        pre = fmaxf(pre, 0.f);
#pragma unroll
        for (int i = 0; i < 4; ++i) Pms[4 * tid + i] = fmaxf(pre, mx[i]);
        if (tid < 128) Ns[tid] = 0.f;
        LAS float* Cw = (LAS float*)(lds + ML_CW);
        for (int idx = tid; idx < 1280; idx += NTHREADS) { const int t = idx / 640, j = (idx % 640) >> 7, c = idx & 127;
            Cw[idx] = j < 4 ? conv_w[j * 1024 + t * 512 + h * 128 + c] : conv_b[t * 512 + h * 128 + c]; }
        if (tid < 128) ((LAS float*)(lds + ML_GM))[tid] = g_mh[h * 128 + tid];
    }
    const int kq = wave >> 2;
    const bf16_t* s0p = (kq ? B.MQ : B.MK) + rowb * 512 + h * 128;
    const bf16_t* s1p = B.MV + rowb * 512 + h * 128;
    u32x4 raw[11];
#define ML_BAR() asm volatile("s_waitcnt lgkmcnt(0)\n\ts_barrier" ::: "memory")
#define ML_LOAD_RAW(t0_) do { const int r0_ = (t0_) + 4 * rq; \
        _Pragma("unroll") for (int i = 0; i < 7; ++i) raw[i] = (r0_ + i - 3 >= 0) ? *(const u32x4*)(s0p + (so + (unsigned)(r0_ + i - 3) * 512u)) : (u32x4){0u, 0u, 0u, 0u}; \
        if (kq) { _Pragma("unroll") for (int i = 0; i < 4; ++i) raw[7 + i] = *(const u32x4*)(s1p + (so + (unsigned)(r0_ + i) * 512u)); } } while (0)
#define ML_CONV(cc_, osc_) do { const LAS float* cwp_ = (const LAS float*)(lds + ML_CW) + (kq ? 0 : 640) + 8 * co; \
        _Pragma("unroll") for (int hq = 0; hq < 2; ++hq) { \
            f32x4v w_[5]; _Pragma("unroll") for (int j = 0; j < 5; ++j) w_[j] = *(const LAS f32x4v*)(cwp_ + j * 128 + 4 * hq); \
            f32x4v x_[7]; _Pragma("unroll") for (int i = 0; i < 7; ++i) { const unsigned lo_ = hq ? raw[i].z : raw[i].x, hi_ = hq ? raw[i].w : raw[i].y; \
                x_[i][0] = __uint_as_float(lo_ << 16); x_[i][1] = __uint_as_float(lo_ & 0xffff0000u); x_[i][2] = __uint_as_float(hi_ << 16); x_[i][3] = __uint_as_float(hi_ & 0xffff0000u); } \
            _Pragma("unroll") for (int rr = 0; rr < 4; ++rr) { f32x4v a_ = w_[4]; _Pragma("unroll") for (int j = 0; j < 4; ++j) a_ += w_[j] * x_[rr + j]; \
                _Pragma("unroll") for (int e = 0; e < 4; ++e) a_[e] = a_[e] * fast_sigmoid(a_[e]) * (osc_); \
                const unsigned p0_ = cvt_pk_bf16(a_[0], a_[1]), p1_ = cvt_pk_bf16(a_[2], a_[3]); if (hq) { cc_[rr].z = p0_; cc_[rr].w = p1_; } else { cc_[rr].x = p0_; cc_[rr].y = p1_; } } } } while (0)
    { const int rq = (tid >> 4) & 15, co = tid & 15; const unsigned so = 8u * (unsigned)co; ML_LOAD_RAW(0); }
    const bf16_t* mob = B.MO + rowb * 512 + h * 128;
    f32x4v Cacc[8];
#pragma unroll
    for (int i = 0; i < 8; ++i) Cacc[i] = (f32x4v){0.f, 0.f, 0.f, 0.f};
    __syncthreads();
#pragma unroll 1
    for (int c = 0; c < SEQ / 64; ++c) {
        const int t0 = c * 64;
        int tl = tid; asm volatile("" : "+v"(tl));
        const int rq = (tl >> 4) & 15, co = tl & 15, l15 = tl & 15, q4 = (tl >> 4) & 3, rp_t = tl >> 3, rp_part = tl & 7; const unsigned so = 8u * (unsigned)co;
        const float Rc = c == 0 ? 0.f : Pms[t0 - 1], Rn = Pms[t0 + 63];
        asm volatile("" : "+v"(raw[0]), "+v"(raw[1]), "+v"(raw[2]), "+v"(raw[3]), "+v"(raw[4]), "+v"(raw[5]), "+v"(raw[6]), "+v"(raw[7]), "+v"(raw[8]), "+v"(raw[9]), "+v"(raw[10]));
        u32x4 cc[4]; ML_CONV(cc, kq ? MLQ_SCALE : 1.f);
        if (kq == 0) {
            float gs[4];
#pragma unroll
            for (int rr = 0; rr < 4; ++rr) { gs[rr] = __expf(As[t0 + 4 * rq + rr] - Rn); *(LAS u32x4*)(Ks + (4 * rq + rr) * ML_QLD + 8 * co) = cc[rr]; }
            float kf[4][8];
#pragma unroll
            for (int rr = 0; rr < 4; ++rr) bf8_to_f32(cc[rr], kf[rr]);
#pragma unroll
            for (int i = 0; i < 8; ++i) { u32x2 w; w.x = cvt_pk_bf16(kf[0][i] * gs[0], kf[1][i] * gs[1]); w.y = cvt_pk_bf16(kf[2][i] * gs[2], kf[3][i] * gs[3]);
                *(LAS u32x2*)(KgT + tsw(8 * co + i, 4 * rq)) = w; }
        } else {
#pragma unroll
            for (int rr = 0; rr < 4; ++rr) *(LAS u32x4*)(Qs + (4 * rq + rr) * ML_QLD + 8 * co) = cc[rr];
            unsigned vv[4][4];
#pragma unroll
            for (int rr = 0; rr < 4; ++rr) { vv[rr][0] = raw[7 + rr].x; vv[rr][1] = raw[7 + rr].y; vv[rr][2] = raw[7 + rr].z; vv[rr][3] = raw[7 + rr].w; }
#pragma unroll
            for (int i = 0; i < 8; ++i) { const int wd = i >> 1; u32x2 w;
                if (i & 1) { w.x = (vv[0][wd] >> 16) | (vv[1][wd] & 0xffff0000u); w.y = (vv[2][wd] >> 16) | (vv[3][wd] & 0xffff0000u); }
                else       { w.x = (vv[0][wd] & 0xffffu) | (vv[1][wd] << 16);     w.y = (vv[2][wd] & 0xffffu) | (vv[3][wd] << 16); }
                *(LAS u32x2*)(VT + tsw(8 * co + i, 4 * rq)) = w; }
        }
        ML_BAR();
        {
            const int ti = wave >> 1;
#pragma unroll
            for (int jj = 0; jj < 2; ++jj) { const int sj = 2 * (wave & 1) + jj;
                f32x4v acc = {0.f, 0.f, 0.f, 0.f};
#pragma unroll
                for (int ks = 0; ks < 4; ++ks) { const bf16x8 af = *(const LAS bf16x8*)(Qs + (16 * ti + l15) * ML_QLD + 32 * ks + 8 * q4), bfr = *(const LAS bf16x8*)(Ks + (16 * sj + l15) * ML_QLD + 32 * ks + 8 * q4);
                    acc = __builtin_amdgcn_mfma_f32_16x16x32_bf16(af, bfr, acc, 0, 0, 0); }
                const int s = 16 * sj + l15; const float as = As[t0 + s];
#pragma unroll
                for (int r = 0; r < 4; ++r) { const int t = 16 * ti + 4 * q4 + r; const float p = s <= t ? acc[r] * __expf(as - Pms[t0 + t]) : 0.f; Ps[t * ML_TLD + s] = f2bf(p); }
            }
        }
        ML_BAR();
        {
            const int t = tid >> 3, part = tid & 7; float qn = 0.f, ps = 0.f;
            float qv[8], qw[8]; bf8_to_f32(*(const LAS u32x4*)(Qs + t * ML_QLD + 16 * part), qv); bf8_to_f32(*(const LAS u32x4*)(Qs + t * ML_QLD + 16 * part + 8), qw);
            const f32x4v n0 = *(const LAS f32x4v*)(Ns + 16 * part), n1 = *(const LAS f32x4v*)(Ns + 16 * part + 4), n2 = *(const LAS f32x4v*)(Ns + 16 * part + 8), n3 = *(const LAS f32x4v*)(Ns + 16 * part + 12);
#pragma unroll
            for (int i = 0; i < 4; ++i) qn += qv[i] * n0[i] + qv[4 + i] * n1[i] + qw[i] * n2[i] + qw[4 + i] * n3[i];
            float pv8[8]; bf8_to_f32(*(const LAS u32x4*)(Ps + t * ML_TLD + 8 * part), pv8);
#pragma unroll
            for (int i = 0; i < 8; ++i) ps += pv8[i];
            qn += __shfl_xor(qn, 1); qn += __shfl_xor(qn, 2); qn += __shfl_xor(qn, 4);
            ps += __shfl_xor(ps, 1); ps += __shfl_xor(ps, 2); ps += __shfl_xor(ps, 4);
            if (part == 0) { const float den = __expf(Rc - Pms[t0 + t]) * qn + ps; Dens[t] = 1.f / fmaxf(fabsf(den), __expf(-(Bcs[t0 + t] + Pms[t0 + t]))); }
        }
        f32x4v no[4];
#pragma unroll
        for (int ti = 0; ti < 4; ++ti) no[ti] = (f32x4v){0.f, 0.f, 0.f, 0.f};
        if (c > 0) {
#pragma unroll
            for (int kk = 0; kk < 4; ++kk) {
                u32x4 cb4; cb4.x = cvt_pk_bf16(Cacc[2 * kk][0], Cacc[2 * kk][1]); cb4.y = cvt_pk_bf16(Cacc[2 * kk][2], Cacc[2 * kk][3]); cb4.z = cvt_pk_bf16(Cacc[2 * kk + 1][0], Cacc[2 * kk + 1][1]); cb4.w = cvt_pk_bf16(Cacc[2 * kk + 1][2], Cacc[2 * kk + 1][3]);
                const bf16x8 cfrag = __builtin_bit_cast(bf16x8, cb4);
#pragma unroll
                for (int ti = 0; ti < 4; ++ti) { const LAS bf16_t* qp = Qs + (16 * ti + l15) * ML_QLD + 32 * kk + 4 * q4;
                    const u32x2 lo = *(const LAS u32x2*)qp, hi = *(const LAS u32x2*)(qp + 16);
                    u32x4 x; x.x = lo.x; x.y = lo.y; x.z = hi.x; x.w = hi.y;
                    no[ti] = __builtin_amdgcn_mfma_f32_16x16x32_bf16(__builtin_bit_cast(bf16x8, x), cfrag, no[ti], 0, 0, 0); }
            }
#pragma unroll
            for (int ti = 0; ti < 4; ++ti) { const f32x4v pm4 = *(const LAS f32x4v*)(Pms + t0 + 16 * ti + 4 * q4);
#pragma unroll
                for (int r = 0; r < 4; ++r) no[ti][r] *= __expf(Rc - pm4[r]); }
        }
        const bf16x8 vfr0 = *(const LAS bf16x8*)(VT + tsw(16 * wave + l15, 8 * q4)), vfr1 = *(const LAS bf16x8*)(VT + tsw(16 * wave + l15, 32 + 8 * q4));
#pragma unroll
        for (int ti = 0; ti < 4; ++ti) { const bf16x8 pf0 = *(const LAS bf16x8*)(Ps + (16 * ti + l15) * ML_TLD + 8 * q4), pf1 = *(const LAS bf16x8*)(Ps + (16 * ti + l15) * ML_TLD + 32 + 8 * q4);
            no[ti] = __builtin_amdgcn_mfma_f32_16x16x32_bf16(pf0, vfr0, no[ti], 0, 0, 0); no[ti] = __builtin_amdgcn_mfma_f32_16x16x32_bf16(pf1, vfr1, no[ti], 0, 0, 0); }
        ML_BAR();
        u32x4 mo_cur[2]; { const unsigned moo = (unsigned)((t0 + rp_t) * 512 + 16 * rp_part); mo_cur[0] = *(const u32x4*)(mob + moo); mo_cur[1] = *(const u32x4*)(mob + (moo + 8u)); }
        if (c + 1 < SEQ / 64) ML_LOAD_RAW(t0 + 64);
#pragma unroll
        for (int ti = 0; ti < 4; ++ti)
#pragma unroll
            for (int r = 0; r < 4; ++r) Hs[(16 * ti + 4 * q4 + r) * ML_HLD + 16 * wave + l15] = no[ti][r];
        {
            const float decay = __expf(Rc - Rn);
#pragma unroll
            for (int dt = 0; dt < 8; ++dt) Cacc[dt] = Cacc[dt] * decay;
#pragma unroll
            for (int dt = 0; dt < 8; ++dt) { const bf16x8 kf0 = *(const LAS bf16x8*)(KgT + tsw(16 * dt + l15, 8 * q4)), kf1 = *(const LAS bf16x8*)(KgT + tsw(16 * dt + l15, 32 + 8 * q4));
                Cacc[dt] = __builtin_amdgcn_mfma_f32_16x16x32_bf16(kf0, vfr0, Cacc[dt], 0, 0, 0); Cacc[dt] = __builtin_amdgcn_mfma_f32_16x16x32_bf16(kf1, vfr1, Cacc[dt], 0, 0, 0); }
            { const int d = tid >> 2, part = tid & 3; float kv[8], kw[8]; bf8_to_f32(*(const LAS u32x4*)(KgT + tsw(d, 16 * part)), kv); bf8_to_f32(*(const LAS u32x4*)(KgT + tsw(d, 16 * part + 8)), kw);
              float s = 0.f;
#pragma unroll
              for (int i = 0; i < 8; ++i) s += kv[i] + kw[i];
              s += __shfl_xor(s, 1); s += __shfl_xor(s, 2);
              if (part == 0) Ns[d] = decay * Ns[d] + s; }
        }
        ML_BAR();
        {
            const int t = tid >> 3, part = tid & 7; const float inv = Dens[t];
            const LAS f32x4v* hp = (const LAS f32x4v*)(Hs + t * ML_HLD + 16 * part);
            f32x4v hq[4]; float sq = 0.f;
#pragma unroll
            for (int i = 0; i < 4; ++i) { hq[i] = hp[i] * inv; sq += dot4(hq[i]); }
            sq += __shfl_xor(sq, 1); sq += __shfl_xor(sq, 2); sq += __shfl_xor(sq, 4);
            const float rs = rsqrtf(sq * (1.f / 128.f) + EPS);
            const size_t row = rowb + t0 + t;
            float mo[8], mo2[8];
            bf8_to_f32(mo_cur[0], mo); bf8_to_f32(mo_cur[1], mo2);
            f32x4v o0, o1, o2, o3;
            const LAS f32x4v* gp = (const LAS f32x4v*)(lds + ML_GM) + 4 * part; const f32x4v g0 = gp[0], g1 = gp[1], g2 = gp[2], g3 = gp[3];
#pragma unroll
            for (int i = 0; i < 4; ++i) { o0[i] = hq[0][i] * rs * g0[i] * mo[i]; o1[i] = hq[1][i] * rs * g1[i] * mo[4 + i]; o2[i] = hq[2][i] * rs * g2[i] * mo2[i]; o3[i] = hq[3][i] * rs * g3[i] * mo2[4 + i]; }
            bf16_t* op = B.MIX + row * 1024 + 512 + h * 128 + 16 * part;
            *(u32x4*)op = pack8(o0, o1); *(u32x4*)(op + 8) = pack8(o2, o3);
        }
    }
#undef ML_LOAD_RAW
#undef ML_CONV
#undef ML_BAR
}

__device__ __forceinline__ void phase_idxml(const Args& a, const Bufs& B, LAS unsigned char* lds, int L, int rep, int bid, int G, int wave, int lane, bool grp) {
    const int x = grp ? (bid & 7) : 0, rank = grp ? (bid >> 3) : bid, nrank = grp ? 32 : G, dsh = grp ? 1 : 4, bb = x << dsh, nml = 4 << dsh, nit = 128 << dsh;
#pragma unroll 1
    for (int item = rank; item < nml; item += nrank) mlstm_item(B, lds, bb + (item >> 2), item & 3, wave, lane, a.in[15] + L * 512, a.in[11] + (size_t)L * 4 * 1024, a.in[12] + L * 1024);
    { unsigned m1 = ~0u; asm volatile("" : "+s"(m1)); lane = (int)__builtin_amdgcn_mbcnt_hi(m1, __builtin_amdgcn_mbcnt_lo(m1, 0u)); }
    unsigned* qctr = (unsigned*)(a.ws + WS_CTL) + 220000 + 64 * (8 * (L + 2 * rep) + x);
    volatile LAS int* slot = (volatile LAS int*)(lds + LDS_BYTES - 128);
    const bool ldr = (wave == 0) && (lane == 0);
    __syncthreads();
    if (ldr) slot[0] = (int)__hip_atomic_fetch_add(qctr, 1u, __ATOMIC_RELAXED, __HIP_MEMORY_SCOPE_AGENT);
    __syncthreads();
    int it = __builtin_amdgcn_readfirstlane(slot[0]), cur = 0;
    IdxPre P, Pn;
    if (it < nit) idx_preload(P, B, bb + (it & ((1 << dsh) - 1)), 127 - (it >> dsh), wave, lane);
    while (it < nit) {
        int nxt = 0;
        if (ldr) nxt = (int)__hip_atomic_fetch_add(qctr, 1u, __ATOMIC_RELAXED, __HIP_MEMORY_SCOPE_AGENT);
        it = idx_wg_item(B, lds, bb + (it & ((1 << dsh) - 1)), 127 - (it >> dsh), wave, lane, P, Pn, slot + 1 + cur, ldr, nxt, dsh, bb);
        P = Pn; cur ^= 1;
    }
}
__device__ __forceinline__ void phase_mix(const Args& a, const Bufs& B, LAS unsigned char* lds, int L, int rep, int bid, int G, int wave, int lane, bool grp) {
#ifndef PROBE_ML
#define PROBE_ML 1
#endif
#ifndef PROBE_ATT
#define PROBE_ATT 1
#endif
#ifdef PROBE_SKIP
    const bool pfx = (a.bar_slot == 0);
#else
    const bool pfx = false;
#endif
#ifndef PROBE_SKIP
#define PROBE_SKIP 0
#endif
    (void)pfx;
#pragma unroll 1
    for (int r = 0; r < PROBE_ATT; ++r) {
        if (pfx && PROBE_SKIP == 1) break;
        const int x = grp ? (bid & 7) : 0, dsh = grp ? 1 : 4, bb = x << dsh, nit = 32 << dsh;
        unsigned* qctr = (unsigned*)(a.ws + WS_CTL) + 200000 + 64 * (8 * (L + 2 * r) + x);
        for (;;) {
            int so = LDS_BYTES - 128; unsigned m1 = ~0u; asm volatile("" : "+s"(so), "+s"(m1));
            volatile LAS int* slot = (volatile LAS int*)(lds + so); lane = (int)__builtin_amdgcn_mbcnt_hi(m1, __builtin_amdgcn_mbcnt_lo(m1, 0u));
            __syncthreads();
            if (wave == 0 && lane == 0) slot[0] = (int)__hip_atomic_fetch_add(qctr, 1u, __ATOMIC_RELAXED, __HIP_MEMORY_SCOPE_AGENT);
            __syncthreads();
            const int it = __builtin_amdgcn_readfirstlane(slot[0]);
            if (it >= nit) break;
            const int b = bb + (it & ((1 << dsh) - 1)), qb = 31 - (it >> dsh);
            att_wg_item(B, lds, b, qb, wave, lane);
        }
    }
}
constexpr int PH_PER_LAYER = 9, PH_TOTAL = 1 + DEPTH * PH_PER_LAYER;
__host__ __device__ __forceinline__ Bufs make_bufs(unsigned char* ws, float* out) {
    Bufs B;
    B.HB = (bf16_t*)(ws + WS_HB); B.SS = (float*)(ws + WS_SS); B.ROPE = (float*)(ws + WS_ROPE); B.CQ = (bf16_t*)(ws + WS_CQ); B.CQSS = (float*)(ws + WS_CQSS);
    B.IW = (float*)(ws + WS_IW); B.MI = (float*)(ws + WS_MI); B.MF = (float*)(ws + WS_MF); B.K = (bf16_t*)(ws + WS_K); B.VT = (bf16_t*)(ws + WS_VT);
    B.IK = (bf16_t*)(ws + WS_IK); B.SEL = (unsigned*)(ws + WS_SEL); B.Q = (bf16_t*)(ws + WS_Q); B.IQ = (bf16_t*)(ws + WS_IQ); B.MQ = (bf16_t*)(ws + WS_MQ);
    B.MK = (bf16_t*)(ws + WS_MK); B.MV = (bf16_t*)(ws + WS_MV); B.MO = (bf16_t*)(ws + WS_MO); B.MIX = (bf16_t*)((unsigned char*)out + 64 * MiB); B.PW0 = (bf16_t*)(ws + WS_PW0); B.PW1 = (bf16_t*)(ws + WS_PW1) - (size_t)PW_SPLIT_PM * 256 * DM;
    B.PB = (bf16_t*)(ws + WS_PB); B.U = (bf16_t*)(ws + WS_U);
    return B;
}

#ifndef REPEAT_MASK
#define REPEAT_MASK 0
#endif
#define PH_REP(k) for (int rep_ = 0; rep_ < (((REPEAT_MASK >> (k)) & 1) ? 2 : 1); ++rep_)
#define PH_IN(p) (lo <= (p) && (p) < hi)
#define PH_SYNC(p) do { if ((p) > lo) xcd_barrier(bar, leader); } while (0)
#define PH_GSYNC(p, idx, arr, wt) do { if ((p) > lo) { const unsigned gm_ = (unsigned)__builtin_amdgcn_readfirstlane((int)bar.st[2]); if (gm_ & 1u) grp_barrier((unsigned*)(a.ws + WS_CTL), bar, gm_, (unsigned)(L * 7 + (idx)), leader, (arr), (wt)); else xcd_barrier(bar, leader); } } while (0)
template <int L>
__device__ __forceinline__ void layer_phases(const Args& a, LAS unsigned char* lds, const XcdBarrier& bar, const int wave, const int lo, const int hi) {
    constexpr int pb = 1 + L * PH_PER_LAYER;
    const int G = gridDim.x, bid = blockIdx.x; const bool leader = (wave == 0) && (__lane_id() == 0);
    if (PH_IN(pb + 0)) { PH_SYNC(pb + 0);
        if (L == 0) {
            const bool use = (gridDim.x == 256u && lo == 0); unsigned* ctl = (unsigned*)(a.ws + WS_CTL);
            if (wave == 0) { unsigned m1 = ~0u; asm volatile("" : "+s"(m1)); const int ln = (int)__builtin_amdgcn_mbcnt_hi(m1, __builtin_amdgcn_mbcnt_lo(m1, 0u));
                const unsigned id = use ? xb_ld(&ctl[GB_XID + (blockIdx.x & 7) + 8 * (ln & 31)]) : 0u; const bool same = (id == xb_xcc_id() + 1u); if (ln == 0) bar.st[2] = use ? (__all(same) ? 3u : 1u) : 0u; }
            __syncthreads();
        }
        PH_REP(0) {
        const Bufs B = make_bufs(a.ws, a.out); unsigned char* wb = a.ws + WS_W + (size_t)L * W_LSTRIDE; pg8::StaticOrder S;
        pg8::Gemm g{(const bf16_t*)a.out, (const bf16_t*)(wb + WO_IN), M, NPROJ, DM}; S.init(M, NPROJ, G, bid);
        EpiProj E{B, B.SS, a.in[9] + L * 64, a.in[10] + L * 64, a.in[13] + L * 4, a.in[14] + L * 4}; pg8::gemm_phase(lds, g, S, E, wave); } }
    if (PH_IN(pb + 1)) { PH_GSYNC(pb + 1, 1, -1, -1); PH_REP(1) {
        const Bufs B = make_bufs(a.ws, a.out); unsigned char* wb = a.ws + WS_W + (size_t)L * W_LSTRIDE; pg8::StaticOrder S;
        pg8::Gemm g{B.CQ, (const bf16_t*)(wb + WO_QUP), M, 1024, QR}; S.init(M, 1024, G, bid);
        EpiQup E{B, a.in[8] + L * 64, (const int*)a.in[2]}; pg8::gemm_phase(lds, g, S, E, wave); } }
    if (PH_IN(pb + 2)) { PH_GSYNC(pb + 2, 2, -1, -1); PH_REP(2) {
        const Bufs B = make_bufs(a.ws, a.out); phase_idxml(a, B, lds, L, rep_, bid, G, wave, (int)__lane_id(), (__builtin_amdgcn_readfirstlane((int)bar.st[2]) & 1) != 0); } }
    if (PH_IN(pb + 3)) { PH_GSYNC(pb + 3, 3, -1, -1); PH_REP(3) {
        const Bufs B = make_bufs(a.ws, a.out);
        phase_mix(a, B, lds, L, rep_, bid, G, wave, (int)__lane_id(), (__builtin_amdgcn_readfirstlane((int)bar.st[2]) & 1) != 0);
        } }
    if (PH_IN(pb + 4)) { PH_GSYNC(pb + 4, 4, L, -1); PH_REP(4) {
        const Bufs B = make_bufs(a.ws, a.out); unsigned char* wb = a.ws + WS_W + (size_t)L * W_LSTRIDE; pg8::StaticOrder S;
        pg8::Gemm g{B.MIX, (const bf16_t*)(wb + WO_OUT), M, DM, DM}; S.init(M, DM, G, bid);
#ifdef PROBE_WOUT
        { EpiRes E0{L == 0 ? a.in[0] : a.out, (float*)B.U, B.U + (size_t)M * 2048, B.SS + (size_t)2 * M * 16}; pg8::gemm_phase(lds, g, S, E0, wave); }
#endif
        { EpiResB<false> E{(const bf16_t*)a.out, B.HB, B.SS + (size_t)M * 16}; pg8::gemm_phase(lds, g, S, E, wave); } } }
    if (PH_IN(pb + 5)) { PH_GSYNC(pb + 5, 5, (L + 1 < DEPTH) ? -1 : 2, L); PH_REP(5) {
        const Bufs B = make_bufs(a.ws, a.out); unsigned char* wb = a.ws + WS_W + (size_t)L * W_LSTRIDE; pg8::StaticOrder S;
        pg8::Gemm g{B.HB, (const bf16_t*)(wb + WO_F1), M, DFF, DM}; S.init(M, DFF, G, bid);
        EpiFF1 E{B.SS + (size_t)M * 16, B.U}; pg8::gemm_phase(lds, g, S, E, wave); } }
    if (PH_IN(pb + 6)) { PH_GSYNC(pb + 6, 6, -1, -1); PH_REP(6) {
        const Bufs B = make_bufs(a.ws, a.out); unsigned char* wb = a.ws + WS_W + (size_t)L * W_LSTRIDE; pg8::StaticOrder S;
        pg8::Gemm g{B.U, (const bf16_t*)(wb + WO_F2), M, DM, DFF}; S.init(M, DM, G, bid); S.rev = true;
        EpiResB<false> E{B.HB, B.HB, B.SS + (size_t)2 * M * 16}; pg8::gemm_phase<EpiResB<false>, true>(lds, g, S, E, wave); } }
    if (PH_IN(pb + 7)) { PH_REP(7) {
        const Bufs B = make_bufs(a.ws, a.out); unsigned char* wb = a.ws + WS_W + (size_t)L * W_LSTRIDE; pg8::StaticOrder S;
        pg8::Gemm g{B.PB + (size_t)L * M * PLE, (const bf16_t*)(wb + WO_P), M, DM, PLE}; S.init(M, DM, G, bid);
        EpiPW E{B.PW0, B.PW1}; pg8::gemm_phase(lds, g, S, E, wave); } }
    if (PH_IN(pb + 8)) { PH_GSYNC(pb + 8, 7, -1, (L + 1 < DEPTH) ? -1 : 2); PH_REP(8) {
        const Bufs B = make_bufs(a.ws, a.out); unsigned char* wb = a.ws + WS_W + (size_t)L * W_LSTRIDE; pg8::StaticOrder S;
        pg8::Gemm g{B.HB, (const bf16_t*)(wb + WO_G), M, DM, DM}; S.init(M, DM, G, bid);
        if (L + 1 < DEPTH) { EpiGateB<false> E{B.SS + (size_t)2 * M * 16, a.in[22] + L * DM, B.PW0, B.PW1, B.HB, nullptr, (bf16_t*)a.out, B.SS}; pg8::gemm_phase(lds, g, S, E, wave); }
        else { EpiGateB<true> E{B.SS + (size_t)2 * M * 16, a.in[22] + L * DM, B.PW0, B.PW1, B.HB, a.out, nullptr, nullptr}; pg8::gemm_phase(lds, g, S, E, wave); } } }
}

__global__ void __launch_bounds__(NTHREADS, 2) mega(Args a) {
    extern __shared__ __attribute__((aligned(16))) unsigned char lds_raw[];
    LAS unsigned char* lds = (LAS unsigned char*)lds_raw;
    const int wave = __builtin_amdgcn_readfirstlane((int)(threadIdx.x >> 6));
    const bool leader = (wave == 0) && (__lane_id() == 0);
    volatile LAS unsigned* st = (volatile LAS unsigned*)(lds + LDS_BYTES - 64);
    if (leader) { st[0] = 0u; st[1] = 0u; }
    __syncthreads();
    const XcdBarrier bar = xcd_barrier_post((unsigned*)(a.ws + WS_CTL) + a.bar_slot * XCD_BAR_WORDS, st, leader);
    cg::this_grid().sync();
    const int lo = a.ph_lo, hi = a.ph_hi;
    if (leader) { unsigned xv = xb_xcc_id() + 1u; (void)xb_add((unsigned*)(a.ws + WS_CTL) + GB_XID + blockIdx.x, xv); }
#ifdef PROBE_BAR
#pragma unroll 1
    for (int i = 0; i < PROBE_BAR; ++i) xcd_barrier(bar, leader);
#endif
#ifndef PROBE_P0
#define PROBE_P0 1
#endif
    if (PH_IN(0)) for (int rep_ = 0; rep_ < PROBE_P0; ++rep_) { const Bufs B = make_bufs(a.ws, a.out); phase_prologue(a, B, lds, blockIdx.x * NWAVES + wave, gridDim.x * NWAVES, wave, (int)__lane_id()); }
    layer_phases<0>(a, lds, bar, wave, lo, hi);
    layer_phases<1>(a, lds, bar, wave, lo, hi);
}

static int g_grid = 0;
static int g_slot = 0;
static void launch_mega(const Args& base, int lo, int hi, hipStream_t stream) {
    Args a = base; a.ph_lo = lo; a.ph_hi = hi; a.bar_slot = g_slot++;
    void* args[] = {&a};
    hipError_t e = hipLaunchCooperativeKernel((const void*)mega, dim3(g_grid), dim3(NTHREADS), args, LDS_BYTES, stream);
    if (e != hipSuccess) fprintf(stderr, "kernel_launch: cooperative launch [%d,%d) failed: %s (grid %d)\n", lo, hi, hipGetErrorString(e), g_grid);
}

extern "C" void kernel_launch(void* const* d_in, const int* in_sizes, int n_in, void* d_out, int out_size, void* d_ws, size_t ws_size, hipStream_t stream) {
    if (n_in != 24 || ws_size < WS_END) { fprintf(stderr, "kernel_launch: unexpected n_in %d or ws %zu\n", n_in, ws_size); return; }
    if (g_grid == 0) {
        int dev = 0, cus = 0, per_cu = 0;
        hipGetDevice(&dev); hipDeviceGetAttribute(&cus, hipDeviceAttributeMultiprocessorCount, dev);
        if (hipFuncSetAttribute((const void*)mega, hipFuncAttributeMaxDynamicSharedMemorySize, LDS_BYTES) != hipSuccess) { fprintf(stderr, "kernel_launch: hipFuncSetAttribute failed\n"); g_grid = -1; return; }
        if (hipOccupancyMaxActiveBlocksPerMultiprocessor(&per_cu, (const void*)mega, NTHREADS, LDS_BYTES) != hipSuccess || per_cu < 1) { fprintf(stderr, "kernel_launch: occupancy query failed (%d)\n", per_cu); g_grid = -1; return; }
        g_grid = cus * per_cu;
        fprintf(stderr, "kernel_launch: %d CUs x %d blocks/CU -> grid %d\n", cus, per_cu, g_grid);
    }
    if (g_grid < 0) return;
    float* OUT = (float*)d_out; unsigned char* ws = (unsigned char*)d_ws;
    Args a{};
    for (int i = 0; i < 24; ++i) a.in[i] = (const float*)d_in[i];
    a.out = OUT; a.ws = ws;

    g_slot = 0;
    if (hipMemsetAsync(ws + WS_CTL, 0, 1 * MiB, stream) != hipSuccess) { fprintf(stderr, "kernel_launch: memset failed\n"); return; }
#ifdef PROBE_PREFIX
    launch_mega(a, 0, PROBE_PREFIX, stream);
    if (hipMemsetAsync(ws + WS_CTL, 0, 1 * MiB, stream) != hipSuccess) return;
#endif
    launch_mega(a, 0, PH_TOTAL, stream);
}
```

```cpp
#include <hip/hip_runtime.h>
#include <cstdint>
#include <cstdio>
#include <cmath>
#include <hip/hip_cooperative_groups.h>
namespace cg = cooperative_groups;

constexpr int DM = 1024, BATCH = 16, SEQ = 2048, DEPTH = 2, M = BATCH * SEQ;
constexpr int PLE = 256, QR = 256, TOPK = 256, DFF = 4096, IN_W = 2640;
constexpr int C_CQ = 0, C_AK = 256, C_AV = 384, C_IK = 512, C_IW = 576, C_MQ = 584, C_MK = 1096, C_MV = 1608, C_MO = 2120, C_MI = 2632, C_MF = 2636;
constexpr float EPS = 1e-6f;
constexpr float IDX_SCALE = 0.04419417382415922f;
constexpr float QSCALE = 0.125f * 1.4426950408889634f;
constexpr float MLQ_SCALE = 0.08838834764831845f;

typedef uint16_t bf16_t;
__device__ __forceinline__ float bf2f(bf16_t v) { return __uint_as_float(((unsigned)v) << 16); }
__device__ __forceinline__ bf16_t f2bf(float f) { unsigned u = __float_as_uint(f); return (bf16_t)((u + 0x7fffu + ((u >> 16) & 1u)) >> 16); }

constexpr size_t MiB = 1u << 20;
constexpr size_t WS_HB = 0;
constexpr size_t WS_SS = 64 * MiB;
constexpr size_t WS_ROPE = 70 * MiB;
constexpr size_t WS_CQ = 72 * MiB;
constexpr size_t WS_CQSS = 88 * MiB;
constexpr size_t WS_IW = 89 * MiB;
constexpr size_t WS_MI = 90 * MiB;
constexpr size_t WS_MF = 91 * MiB;
constexpr size_t WS_K = 92 * MiB;
constexpr size_t WS_VT = 100 * MiB;
constexpr size_t WS_IK = 108 * MiB;
constexpr size_t WS_SEL = 112 * MiB;
constexpr size_t WS_Q = 120 * MiB;
constexpr size_t WS_IQ = 152 * MiB;
constexpr size_t WS_MQ = 184 * MiB;
constexpr size_t WS_MK = 216 * MiB;
constexpr size_t WS_MV = 248 * MiB;
constexpr size_t WS_MO = 280 * MiB;
constexpr size_t WS_PW0 = 72 * MiB;
constexpr size_t WS_PW1 = 472 * MiB;
constexpr int PW_SPLIT_PM = 96;
constexpr size_t WS_PB = 440 * MiB;
constexpr size_t WS_U = 120 * MiB;
constexpr size_t WS_END = 488 * MiB;

struct Bufs {
    bf16_t *HB, *CQ, *K, *VT, *IK, *Q, *IQ, *MQ, *MK, *MV, *MO, *MIX, *PW0, *PW1, *PB, *U;
    float *SS, *ROPE, *CQSS, *IW, *MI, *MF; unsigned* SEL;
};

__device__ __forceinline__ float wave_sum(float v) {
#pragma unroll
    for (int o = 1; o < 64; o <<= 1) v += __shfl_xor(v, o);
    return v;
}
__device__ __forceinline__ float sigmoidf_(float x) { return 1.f / (1.f + __expf(-x)); }
__device__ __forceinline__ float logsigmoidf_(float x) { return fminf(x, 0.f) - log1pf(__expf(-fabsf(x))); }
__device__ __forceinline__ float rs_from_ss(const float* ss16) {
    float s = 0.f;
#pragma unroll
    for (int i = 0; i < 16; ++i) s += ss16[i];
    return rsqrtf(s * (1.f / 1024.f) + EPS);
}

__device__ __forceinline__ unsigned f2ord(float f) { const unsigned u = __float_as_uint(f); return (u & 0x80000000u) ? ~u : (u | 0x80000000u); }

#define LAS __attribute__((address_space(3)))
typedef short bf16x8 __attribute__((ext_vector_type(8)));
typedef float f32x4 __attribute__((ext_vector_type(4)));
typedef float f32x2 __attribute__((ext_vector_type(2)));
typedef unsigned u32x4 __attribute__((ext_vector_type(4)));
typedef unsigned u32x2 __attribute__((ext_vector_type(2)));

constexpr int NWAVES = 8, NTHREADS = 512;
constexpr int LDS_BYTES = 147456;

constexpr size_t WS_W = 376 * MiB, W_LSTRIDE = 28 * MiB;
constexpr size_t WO_IN = 0, WO_QUP = 6 * MiB, WO_OUT = 7 * MiB, WO_F1 = 9 * MiB, WO_F2 = 17 * MiB, WO_G = 25 * MiB, WO_P = 27 * MiB;
constexpr size_t WS_CTL = 432 * MiB;
constexpr int NPROJ = 2816;

__device__ __forceinline__ unsigned cvt_pk_bf16(float lo, float hi) { unsigned r; asm volatile("v_cvt_pk_bf16_f32 %0, %1, %2" : "=v"(r) : "v"(lo), "v"(hi)); return r; }
__device__ __forceinline__ u32x4 pack8(const f32x4 a, const f32x4 b) { u32x4 w; w.x = cvt_pk_bf16(a[0], a[1]); w.y = cvt_pk_bf16(a[2], a[3]); w.z = cvt_pk_bf16(b[0], b[1]); w.w = cvt_pk_bf16(b[2], b[3]); return w; }
__device__ __forceinline__ u32x2 pack4(const f32x4 a) { u32x2 w; w.x = cvt_pk_bf16(a[0], a[1]); w.y = cvt_pk_bf16(a[2], a[3]); return w; }
__device__ __forceinline__ float dot4(const f32x4 a) { return (a[0] * a[0] + a[1] * a[1]) + (a[2] * a[2] + a[3] * a[3]); }
__device__ __forceinline__ float red_fq(float s) { s += __shfl_xor(s, 16); s += __shfl_xor(s, 32); return s; }
__device__ __forceinline__ float fast_sigmoid(float x) { return __builtin_amdgcn_rcpf(1.f + __builtin_amdgcn_exp2f(-1.4426950408889634f * x)); }
__device__ __forceinline__ f32x4 sig4(const f32x4 v) { f32x4 o; o[0] = fast_sigmoid(v[0]); o[1] = fast_sigmoid(v[1]); o[2] = fast_sigmoid(v[2]); o[3] = fast_sigmoid(v[3]); return o; }
__host__ __device__ __forceinline__ int dimmap(int pos) { return pos < 16 ? ((pos & 3) | ((pos & 4) << 1) | ((pos & 8) >> 1)) : pos; }

namespace pg8 {
constexpr int BM = 256, BK = 64, HALF = 128, HTB = HALF * BK * 2, STAGE_BYTES = 8 * HTB, NXCD = 8, WGM = 8;
__host__ __device__ __forceinline__ int lds_byte(int r, int c) { const int st = (r >> 4) * 2 + (c >> 5), rr = r & 15, cc = c & 31, ob = rr * 64 + cc * 2; return st * 1024 + (ob ^ (((ob >> 9) & 1) << 5)); }
__host__ __device__ __forceinline__ void stage_rc(int b, int& R, int& C) { const int st = b / 1024, sb = b % 1024, swz = sb ^ (((sb >> 9) & 1) << 5); R = (st >> 1) * 16 + swz / 64; C = (st & 1) * 32 + (swz % 64) / 2; }
__host__ __device__ __forceinline__ int perm32(int rho) { const int n = rho >> 4, i = rho & 15; return 8 * (i >> 2) + 4 * n + (i & 3); }
struct Unit { int pm, pn; };
struct Gemm { const bf16_t* A; const bf16_t* Bt; int M, N, K; };
struct StaticOrder {
    int nM, nN, nwg, G, c; bool rev = false;
    __host__ __device__ void init(int M_, int N_, int G_, int c_) { nM = M_ / BM; nN = N_ / BM; nwg = nM * nN; G = G_; c = c_; }
    __host__ __device__ bool next(int i, Unit& u) const {
        const long L = (long)i * G + c; if (L >= nwg) return false;
        int wgid = (int)L; { const int q = nwg / NXCD, r = nwg % NXCD, xcd = wgid % NXCD, off = wgid / NXCD; wgid = (xcd < r ? xcd * (q + 1) : r * (q + 1) + (xcd - r) * q) + off; }
        const int nig = WGM * nN, gid = wgid / nig, fm = gid * WGM, gsz = (nM - fm) < WGM ? (nM - fm) : WGM;
        u.pm = fm + ((wgid % nig) % gsz); u.pn = (wgid % nig) / gsz; if (rev) u.pm ^= 15; return true;
    }
};
template <class Epi, bool A_TILED = false>
__device__ __forceinline__ void gemm_phase(LAS unsigned char* lds, const Gemm g, const StaticOrder& S, const Epi& E, const int wave_id) {
    int tid_ = wave_id * 64 + (int)__lane_id(); asm volatile("" : "+v"(tid_));
    const int tid = tid_, wid = __builtin_amdgcn_readfirstlane(tid >> 6), lane = tid & 63, wr = wid >> 2, wc = wid & 3, fr = lane & 15, fq = lane >> 4;
    const int K = g.K, nt = K / BK;
    unsigned voffA[2], voffB[2];
#pragma unroll
    for (int i = 0; i < 2; ++i) { int R, C; stage_rc(tid * 16 + i * 8192, R, C); const int Rb = (R & ~31) + perm32(R & 31);
        voffA[i] = (unsigned)(R * K + C) * 2u; voffB[i] = (unsigned)(Rb * K + C) * 2u;
        if (A_TILED) { const int st = (tid * 16 + i * 8192) >> 10; voffA[i] = (unsigned)((((st >> 1) * (K >> 5) + (st & 1)) << 10) + ((tid * 16) & 1023)); } }
    const size_t kstep = A_TILED ? (size_t)2048 : (size_t)(BK * 2), kstepB = (size_t)(BK * 2);
    const size_t hstep = (size_t)HALF * K * 2;
    const size_t tstep = 2 * hstep;
    const unsigned ldsw = (unsigned)wid * 1024u;
    const int aoff = lds_byte(wr * 64 + fr, fq * 8), boff = lds_byte(wc * 32 + fr, fq * 8);
#define PG8_SA(b, h) (((b) * 2 + (h)) * HTB)
#define PG8_SB(b, h) ((4 + (b) * 2 + (h)) * HTB)
#define PG8_STAGE(bufoff, gbase, voff) do { _Pragma("unroll") for (int _i = 0; _i < 2; ++_i) \
        __builtin_amdgcn_global_load_lds((const unsigned*)((const char*)(gbase) + (voff)[_i]), (LAS unsigned*)(lds + (bufoff) + ldsw + _i * 8192), 16, 0, 0); } while (0)
#define PG8_LDA(dst, b, h) do { _Pragma("unroll") for (int m = 0; m < 4; ++m) _Pragma("unroll") for (int k = 0; k < 2; ++k) dst[m][k] = *(const LAS bf16x8*)(lds + PG8_SA(b, h) + aoff + m * 2048 + k * 1024); } while (0)
#define PG8_LDB(dst, b, h) do { _Pragma("unroll") for (int n = 0; n < 2; ++n) _Pragma("unroll") for (int k = 0; k < 2; ++k) dst[n][k] = *(const LAS bf16x8*)(lds + PG8_SB(b, h) + boff + n * 2048 + k * 1024); } while (0)
#define PG8_MMA(ai, bj, At, Bt) do { __builtin_amdgcn_s_setprio(1); _Pragma("unroll") for (int m = 0; m < 4; ++m) _Pragma("unroll") for (int n = 0; n < 2; ++n) _Pragma("unroll") for (int k = 0; k < 2; ++k) \
        acc[ai][bj][m][n] = __builtin_amdgcn_mfma_f32_16x16x32_bf16(Bt[n][k], At[m][k], acc[ai][bj][m][n], 0, 0, 0); __builtin_amdgcn_s_setprio(0); } while (0)
#define PG8_WAIT_V(n) asm volatile("s_waitcnt vmcnt(" #n ")" ::: "memory")
#define PG8_WAIT_L(n) asm volatile("s_waitcnt lgkmcnt(" #n ")" ::: "memory")
#define PG8_BAR __builtin_amdgcn_s_barrier()
#define PG8_SCHED __builtin_amdgcn_sched_barrier(0)
    Unit cur, nxt; int ui = 0;
    if (!S.next(0, cur)) return;
    typename Epi::Pre pre;
    f32x4 acc[2][2][4][2];
#pragma unroll
    for (int a = 0; a < 2; ++a)
#pragma unroll
        for (int b = 0; b < 2; ++b)
#pragma unroll
            for (int m = 0; m < 4; ++m)
#pragma unroll
                for (int n = 0; n < 2; ++n) acc[a][b][m][n] = (f32x4){0.f, 0.f, 0.f, 0.f};
    bf16x8 At[4][2], B0[2][2], B1[2][2];
    const char* cA = (const char*)g.A + (size_t)cur.pm * tstep; const char* cB = (const char*)g.Bt + (size_t)cur.pn * tstep;
    PG8_STAGE(PG8_SB(0, 0), cB, voffB); PG8_STAGE(PG8_SB(0, 1), cB + hstep, voffB); PG8_STAGE(PG8_SA(0, 0), cA, voffA); PG8_STAGE(PG8_SA(0, 1), cA + hstep, voffA);
    if (wr == 1) PG8_BAR;
    PG8_WAIT_V(2); PG8_BAR;
    PG8_STAGE(PG8_SB(1, 0), cB + kstepB, voffB); PG8_STAGE(PG8_SA(1, 0), cA + kstep, voffA); PG8_STAGE(PG8_SB(1, 1), cB + hstep + kstepB, voffB);
    PG8_WAIT_V(6); PG8_BAR;
    for (;;) {
        const bool has_next = S.next(ui + 1, nxt);
        const char* nA = has_next ? (const char*)g.A + (size_t)nxt.pm * tstep : cA; const char* nB = has_next ? (const char*)g.Bt + (size_t)nxt.pn * tstep : cB;
        for (int t = 0; t < nt; t += 2) {
            const bool last = (t == nt - 2);
            if (last) E.prefetch(pre, cur, wr, wc, fr, fq);
            const char* a1 = cA + (size_t)(t + 1) * kstep;
            const char* a2 = last ? nA : cA + (size_t)(t + 2) * kstep; const char* b2 = last ? nB : cB + (size_t)(t + 2) * kstepB;
            const char* a3 = a2 + kstep; const char* b3 = b2 + kstepB;
            PG8_LDB(B0, 0, 0); PG8_LDB(B1, 0, 1); PG8_SCHED; PG8_LDA(At, 0, 0); PG8_STAGE(PG8_SA(1, 1), a1 + hstep, voffA);
            PG8_WAIT_V(8); PG8_WAIT_L(0); PG8_BAR; PG8_MMA(0, 0, At, B0); PG8_MMA(0, 1, At, B1); PG8_BAR; PG8_SCHED;
            PG8_LDA(At, 0, 1); PG8_STAGE(PG8_SB(0, 0), b2, voffB); PG8_STAGE(PG8_SB(0, 1), b2 + hstep, voffB); PG8_STAGE(PG8_SA(0, 0), a2, voffA);
            PG8_WAIT_V(8); PG8_WAIT_L(0); PG8_BAR; PG8_MMA(1, 0, At, B0); PG8_MMA(1, 1, At, B1); PG8_BAR; PG8_SCHED;
            PG8_LDB(B0, 1, 0); PG8_LDB(B1, 1, 1); PG8_SCHED; PG8_LDA(At, 1, 0); PG8_STAGE(PG8_SA(0, 1), a2 + hstep, voffA);
            PG8_WAIT_V(8); PG8_WAIT_L(0); PG8_BAR; PG8_MMA(0, 0, At, B0); PG8_MMA(0, 1, At, B1); PG8_BAR; PG8_SCHED;
            PG8_LDA(At, 1, 1); PG8_STAGE(PG8_SB(1, 0), b3, voffB); PG8_STAGE(PG8_SB(1, 1), b3 + hstep, voffB); PG8_STAGE(PG8_SA(1, 0), a3, voffA);
            PG8_WAIT_V(8); PG8_WAIT_L(0); PG8_BAR; PG8_MMA(1, 0, At, B0); PG8_MMA(1, 1, At, B1); PG8_BAR; PG8_SCHED;
        }
        if (wr == 0) PG8_BAR;
        E(acc, cur, wr, wc, fr, fq, pre);
        if (!has_next) break;
#pragma unroll
        for (int a = 0; a < 2; ++a)
#pragma unroll
            for (int b = 0; b < 2; ++b)
#pragma unroll
                for (int m = 0; m < 4; ++m)
#pragma unroll
                    for (int n = 0; n < 2; ++n) acc[a][b][m][n] = (f32x4){0.f, 0.f, 0.f, 0.f};
        cur = nxt; cA = nA; cB = nB; ++ui;
        if (wr == 1) PG8_BAR;
    }
    PG8_WAIT_V(0);
    PG8_BAR;
#undef PG8_SA
#undef PG8_SB
#undef PG8_STAGE
#undef PG8_LDA
#undef PG8_LDB
#undef PG8_MMA
#undef PG8_WAIT_V
#undef PG8_WAIT_L
#undef PG8_BAR
#undef PG8_SCHED
}
}
typedef f32x4 Acc[2][2][4][2];

__device__ __forceinline__ float row_rs16(const float* SS, int row, int fq) {
    const f32x4 s4 = *(const f32x4*)(SS + (size_t)row * 16 + 4 * fq);
    return rsqrtf(red_fq((s4[0] + s4[1]) + (s4[2] + s4[3])) * (1.f / 1024.f) + EPS);
}
__device__ __forceinline__ void rs4_load(const float* SS, int rowbase, int fq, float (&rs)[4]) {
    f32x4 s4[4];
#pragma unroll
    for (int m = 0; m < 4; ++m) s4[m] = *(const f32x4*)(SS + (size_t)(rowbase + 16 * m) * 16 + 4 * fq);
#pragma unroll
    for (int m = 0; m < 4; ++m) rs[m] = rsqrtf(red_fq((s4[m][0] + s4[m][1]) + (s4[m][2] + s4[m][3])) * (1.f / 1024.f) + EPS);
}
__device__ __forceinline__ void rs2_load(const float* SS, int rowbase, int fq, float (&rs)[2]) {
    f32x4 s4[2];
#pragma unroll
    for (int m = 0; m < 2; ++m) s4[m] = *(const f32x4*)(SS + (size_t)(rowbase + 16 * m) * 16 + 4 * fq);
#pragma unroll
    for (int m = 0; m < 2; ++m) rs[m] = rsqrtf(red_fq((s4[m][0] + s4[m][1]) + (s4[m][2] + s4[m][3])) * (1.f / 1024.f) + EPS);
}
#define EPI_FENCE() asm volatile("" ::: "memory")

struct EpiRes {
    const float* hin; float* out; bf16_t* HB; float* SSo;
    struct Pre {}; __device__ __forceinline__ void prefetch(Pre&, const pg8::Unit&, int, int, int, int) const {}
    __device__ __forceinline__ void operator()(const Acc& acc, const pg8::Unit& u, int wr, int wc, int fr, int fq, const Pre&) const {
        const int row0 = u.pm * 256 + wr * 64 + fr, col0 = u.pn * 256 + wc * 32 + 8 * fq;
#pragma unroll
        for (int ai = 0; ai < 2; ++ai) {
            f32x4 h[4][2][2];
#pragma unroll
            for (int m = 0; m < 4; ++m)
#pragma unroll
                for (int bj = 0; bj < 2; ++bj) { const size_t off = (size_t)(row0 + ai * 128 + m * 16) * DM + col0 + bj * 128; h[m][bj][0] = *(const f32x4*)(hin + off); h[m][bj][1] = *(const f32x4*)(hin + off + 4); }
#pragma unroll
            for (int m = 0; m < 4; ++m) { const int row = row0 + ai * 128 + m * 16; float sq = 0.f;
#pragma unroll
                for (int bj = 0; bj < 2; ++bj) { const size_t off = (size_t)row * DM + col0 + bj * 128;
                    const f32x4 x0 = h[m][bj][0] + acc[ai][bj][m][0], x1 = h[m][bj][1] + acc[ai][bj][m][1];
                    *(f32x4*)(out + off) = x0; *(f32x4*)(out + off + 4) = x1; *(u32x4*)(HB + off) = pack8(x0, x1); sq += dot4(x0) + dot4(x1); }
                sq = red_fq(sq); if (fq == 0) SSo[(size_t)row * 16 + u.pn * 4 + wc] = sq; }
            EPI_FENCE(); }
    }
};
__device__ __forceinline__ void bf8_unpack(const u32x4 pw, f32x4& p0, f32x4& p1) {
    p0[0] = __uint_as_float(pw.x << 16); p0[1] = __uint_as_float(pw.x & 0xffff0000u); p0[2] = __uint_as_float(pw.y << 16); p0[3] = __uint_as_float(pw.y & 0xffff0000u);
    p1[0] = __uint_as_float(pw.z << 16); p1[1] = __uint_as_float(pw.z & 0xffff0000u); p1[2] = __uint_as_float(pw.w << 16); p1[3] = __uint_as_float(pw.w & 0xffff0000u);
}
template <bool IN_F32> struct EpiResB {
    const void* hin; bf16_t* HBo; float* SSo;
    struct Pre {}; __device__ __forceinline__ void prefetch(Pre&, const pg8::Unit&, int, int, int, int) const {}
    __device__ __forceinline__ void operator()(const Acc& acc, const pg8::Unit& u, int wr, int wc, int fr, int fq, const Pre&) const {
        const int row0 = u.pm * 256 + wr * 64 + fr, col0 = u.pn * 256 + wc * 32 + 8 * fq;
        if (IN_F32) {
#pragma unroll
            for (int ai = 0; ai < 2; ++ai) {
                f32x4 h[4][2][2];
#pragma unroll
                for (int m = 0; m < 4; ++m)
#pragma unroll
                    for (int bj = 0; bj < 2; ++bj) { const size_t off = (size_t)(row0 + ai * 128 + m * 16) * DM + col0 + bj * 128; h[m][bj][0] = *(const f32x4*)((const float*)hin + off); h[m][bj][1] = *(const f32x4*)((const float*)hin + off + 4); }
#pragma unroll
                for (int m = 0; m < 4; ++m) { const int row = row0 + ai * 128 + m * 16; float sq = 0.f;
#pragma unroll
                    for (int bj = 0; bj < 2; ++bj) { const size_t off = (size_t)row * DM + col0 + bj * 128;
                        const f32x4 x0 = h[m][bj][0] + acc[ai][bj][m][0], x1 = h[m][bj][1] + acc[ai][bj][m][1];
                        *(u32x4*)(HBo + off) = pack8(x0, x1); sq += dot4(x0) + dot4(x1); }
                    sq = red_fq(sq); if (fq == 0) SSo[(size_t)row * 16 + u.pn * 4 + wc] = sq; }
                EPI_FENCE(); }
        } else {
            u32x4 hp[2][4][2];
#pragma unroll
            for (int ai = 0; ai < 2; ++ai)
#pragma unroll
                for (int m = 0; m < 4; ++m)
#pragma unroll
                    for (int bj = 0; bj < 2; ++bj) hp[ai][m][bj] = *(const u32x4*)((const bf16_t*)hin + (size_t)(row0 + ai * 128 + m * 16) * DM + col0 + bj * 128);
#pragma unroll
            for (int ai = 0; ai < 2; ++ai)
#pragma unroll
                for (int m = 0; m < 4; ++m) { const int row = row0 + ai * 128 + m * 16; float sq = 0.f;
#pragma unroll
                    for (int bj = 0; bj < 2; ++bj) { const size_t off = (size_t)row * DM + col0 + bj * 128;
                        f32x4 h0, h1; bf8_unpack(hp[ai][m][bj], h0, h1);
                        const f32x4 x0 = h0 + acc[ai][bj][m][0], x1 = h1 + acc[ai][bj][m][1];
                        *(u32x4*)(HBo + off) = pack8(x0, x1); sq += dot4(x0) + dot4(x1); }
                    sq = red_fq(sq); if (fq == 0) SSo[(size_t)row * 16 + u.pn * 4 + wc] = sq; }
        }
    }
};
struct EpiFF1 {
    const float* SS; bf16_t* U;
    struct Pre { float ps[8]; };
    __device__ __forceinline__ void prefetch(Pre& p, const pg8::Unit& u, int wr, int wc, int fr, int fq) const {
        const int row0 = u.pm * 256 + wr * 64 + fr;
#pragma unroll
        for (int i = 0; i < 8; ++i) { const f32x4 s4 = *(const f32x4*)(SS + (size_t)(row0 + (i >> 2) * 128 + (i & 3) * 16) * 16 + 4 * fq); p.ps[i] = (s4[0] + s4[1]) + (s4[2] + s4[3]); }
    }
    __device__ __forceinline__ void operator()(const Acc& acc, const pg8::Unit& u, int wr, int wc, int fr, int fq, const Pre& p) const {
        const int row0 = u.pm * 256 + wr * 64 + fr, col0 = u.pn * 256 + wc * 32 + 8 * fq;
#pragma unroll
        for (int ai = 0; ai < 2; ++ai) {
#pragma unroll
            for (int m = 0; m < 4; ++m) { const int row = row0 + ai * 128 + m * 16; const float rs = rsqrtf(red_fq(p.ps[ai * 4 + m]) * (1.f / 1024.f) + EPS);
#pragma unroll
                for (int bj = 0; bj < 2; ++bj) { f32x4 a = acc[ai][bj][m][0] * rs, b = acc[ai][bj][m][1] * rs;
#pragma unroll
                    for (int j = 0; j < 4; ++j) { a[j] = fmaxf(a[j], 0.f); a[j] *= a[j]; b[j] = fmaxf(b[j], 0.f); b[j] *= b[j]; }
                    const int row16 = row >> 4, col32 = (u.pn * 256 + bj * 128 + wc * 32) >> 5, ob = fr * 64 + 16 * fq;
                    *(u32x4*)((char*)U + (((size_t)row16 * (DFF >> 5) + col32) << 10) + (ob ^ (((ob >> 9) & 1) << 5))) = pack8(a, b); } }
            EPI_FENCE(); }
    }
};
struct EpiPW {
    bf16_t* PW0; bf16_t* PW1;
    struct Pre {}; __device__ __forceinline__ void prefetch(Pre&, const pg8::Unit&, int, int, int, int) const {}
    __device__ __forceinline__ void operator()(const Acc& acc, const pg8::Unit& u, int wr, int wc, int fr, int fq, const Pre&) const {
        const int row0 = u.pm * 256 + wr * 64 + fr, col0 = u.pn * 256 + wc * 32 + 8 * fq;
        bf16_t* PW = u.pm < PW_SPLIT_PM ? PW0 : PW1;
#pragma unroll
        for (int ai = 0; ai < 2; ++ai)
#pragma unroll
            for (int m = 0; m < 4; ++m) { const int row = row0 + ai * 128 + m * 16;
#pragma unroll
                for (int bj = 0; bj < 2; ++bj) *(u32x4*)(PW + (size_t)row * DM + col0 + bj * 128) = pack8(acc[ai][bj][m][0], acc[ai][bj][m][1]); }
    }
};
template <bool FINAL> struct EpiGateB {
    const float* SS; const float* bg; const bf16_t* PW0; const bf16_t* PW1; const bf16_t* hres; float* out; bf16_t* HBo; float* SSo;
    struct Pre {}; __device__ __forceinline__ void prefetch(Pre&, const pg8::Unit&, int, int, int, int) const {}
    __device__ __forceinline__ void operator()(const Acc& acc, const pg8::Unit& u, int wr, int wc, int fr, int fq, const Pre&) const {
        asm volatile("" : "+v"(fr), "+v"(fq));
        const int row0 = u.pm * 256 + wr * 64 + fr, col0 = u.pn * 256 + wc * 32 + 8 * fq;
        const bf16_t* PW = u.pm < PW_SPLIT_PM ? PW0 : PW1;
#pragma unroll
        for (int ai = 0; ai < 2; ++ai)
#pragma unroll
            for (int mp = 0; mp < 2; ++mp) {
                f32x4 s4[2]; u32x4 pw[2][2], hr[2][2];
#pragma unroll
                for (int mm = 0; mm < 2; ++mm) { const int row = row0 + ai * 128 + (2 * mp + mm) * 16; s4[mm] = *(const f32x4*)(SS + (size_t)row * 16 + 4 * fq);
#pragma unroll
                    for (int bj = 0; bj < 2; ++bj) { const size_t off = (size_t)row * DM + col0 + bj * 128; hr[mm][bj] = *(const u32x4*)(hres + off); pw[mm][bj] = *(const u32x4*)(PW + off); } }
#pragma unroll
                for (int mm = 0; mm < 2; ++mm) { const int m = 2 * mp + mm, row = row0 + ai * 128 + m * 16; float sq = 0.f;
                    const float rs = rsqrtf(red_fq((s4[mm][0] + s4[mm][1]) + (s4[mm][2] + s4[mm][3])) * (1.f / 1024.f) + EPS);
#pragma unroll
                    for (int bj = 0; bj < 2; ++bj) { const size_t off = (size_t)row * DM + col0 + bj * 128;
                        f32x4 p0, p1, o0, o1; bf8_unpack(pw[mm][bj], p0, p1); bf8_unpack(hr[mm][bj], o0, o1);
                        const f32x4 b0 = *(const f32x4*)(bg + col0 + bj * 128), b1 = *(const f32x4*)(bg + col0 + bj * 128 + 4);
                        const f32x4 g0 = sig4(acc[ai][bj][m][0] * rs + b0), g1 = sig4(acc[ai][bj][m][1] * rs + b1);
                        const f32x4 x0 = o0 + g0 * p0, x1 = o1 + g1 * p1;
                        if (FINAL) { *(f32x4*)(out + off) = x0; *(f32x4*)(out + off + 4) = x1; }
                        else { *(u32x4*)(HBo + off) = pack8(x0, x1); sq += dot4(x0) + dot4(x1); } }
                    if (!FINAL) { sq = red_fq(sq); if (fq == 0) SSo[(size_t)row * 16 + u.pn * 4 + wc] = sq; } }
                EPI_FENCE(); }
    }
};
__device__ __forceinline__ void head_rope(f32x4 (&v)[2][2], const f32x4 c, const f32x4 s, int fq) {
    if (fq < 2) { const f32x4 x1 = v[0][0], x2 = v[0][1]; v[0][0] = x1 * c - x2 * s; v[0][1] = x2 * c + x1 * s; }
}
__device__ __forceinline__ float head_rs(const f32x4 (&v)[2][2]) { return rsqrtf(red_fq((dot4(v[0][0]) + dot4(v[0][1])) + (dot4(v[1][0]) + dot4(v[1][1]))) * (1.f / 64.f) + EPS); }
__device__ __forceinline__ int head_dq(int bj, int n, int fq) { return bj ? 32 + 8 * fq + 4 * n : (fq < 2 ? 8 * n + 4 * fq : 8 * fq + 4 * n); }
__device__ __forceinline__ void rope_quad(const int pos, const int fodd, f32x4& c, f32x4& s) {
    const float k0[4] = {1.0f, 0.193922758102417f, 0.03760603442788124f, 0.007292665541172028f}, k1[4] = {0.0014142137952148914f, 0.00027424830477684736f, 5.3182971896603703e-05f, 1.031338433676865e-05f};
#pragma unroll
    for (int e = 0; e < 4; ++e) { const float ang = (float)pos * (fodd ? k1[e] : k0[e]); const double rev = (double)ang * 0.15915494309189535; const float fr = (float)(rev - rint(rev));
        c[e] = __builtin_amdgcn_cosf(fr); s[e] = __builtin_amdgcn_sinf(fr); }
}
__device__ __forceinline__ void head_store16(bf16_t* rowp, const f32x4 (&v)[2][2], int fq) {
    const u32x2 p00 = pack4(v[0][0]), p01 = pack4(v[0][1]);
    const u32x2 snd = fq == 0 ? p01 : p00;
    u32x2 rcv; rcv.x = (unsigned)__builtin_amdgcn_ds_swizzle((int)snd.x, 0x401F); rcv.y = (unsigned)__builtin_amdgcn_ds_swizzle((int)snd.y, 0x401F);
    u32x4 w0;
    if (fq == 0) { w0.x = p00.x; w0.y = p00.y; w0.z = rcv.x; w0.w = rcv.y; }
    else if (fq == 1) { w0.x = rcv.x; w0.y = rcv.y; w0.z = p01.x; w0.w = p01.y; }
    else { w0.x = p00.x; w0.y = p00.y; w0.z = p01.x; w0.w = p01.y; }
    *(u32x4*)(rowp + 8 * fq) = w0;
    *(u32x4*)(rowp + 32 + 8 * fq) = pack8(v[1][0], v[1][1]);
}
__device__ __forceinline__ void rope4_load(const float* ROPE, int rowbase, int fq, f32x4 (&c)[4], f32x4 (&s)[4]) {
    const int fo = 4 * (fq & 1);
#pragma unroll
    for (int m = 0; m < 4; ++m) { const float* rp = ROPE + (size_t)(rowbase + 16 * m) * 16 + fo; c[m] = *(const f32x4*)rp; s[m] = *(const f32x4*)(rp + 8); }
}

struct EpiProj {
    Bufs B; const float* SS; const float* g_kn; const float* g_ik; const float* i_bias; const float* f_bias;
    struct Pre {}; __device__ __forceinline__ void prefetch(Pre&, const pg8::Unit&, int, int, int, int) const {}
    __device__ __forceinline__ void operator()(const Acc& acc, const pg8::Unit& u, int wr, int wc, int fr, int fq, const Pre&) const {
        asm volatile("" : "+v"(fr), "+v"(fq));
        const int pn = u.pn, row0 = u.pm * 256 + wr * 64 + fr, colw = wc * 32 + 8 * fq;
        if (pn == 0 || (pn >= 2 && pn <= 9)) {
            bf16_t* dst; int ld, cb;
            if (pn == 0) { dst = B.CQ; ld = 256; cb = 0; } else if (pn < 4) { dst = B.MQ; ld = 512; cb = (pn - 2) * 256; } else if (pn < 6) { dst = B.MK; ld = 512; cb = (pn - 4) * 256; }
            else if (pn < 8) { dst = B.MV; ld = 512; cb = (pn - 6) * 256; } else { dst = B.MO; ld = 512; cb = (pn - 8) * 256; }
            float rs8[8];
            { f32x4 s4[8];
#pragma unroll
              for (int i = 0; i < 8; ++i) s4[i] = *(const f32x4*)(SS + (size_t)(row0 + (i >> 2) * 128 + (i & 3) * 16) * 16 + 4 * fq);
#pragma unroll
              for (int i = 0; i < 8; ++i) rs8[i] = rsqrtf(red_fq((s4[i][0] + s4[i][1]) + (s4[i][2] + s4[i][3])) * (1.f / 1024.f) + EPS); }
#pragma unroll
            for (int ai = 0; ai < 2; ++ai) {
                float rs[4];
#pragma unroll
                for (int m = 0; m < 4; ++m) rs[m] = rs8[ai * 4 + m];
#pragma unroll
                for (int m = 0; m < 4; ++m) { const int row = row0 + ai * 128 + m * 16; float sq = 0.f;
#pragma unroll
                    for (int bj = 0; bj < 2; ++bj) { f32x4 a = acc[ai][bj][m][0] * rs[m], b = acc[ai][bj][m][1] * rs[m];
                        if (pn >= 8) { a = sig4(a); b = sig4(b); }
                        sq += dot4(a) + dot4(b);
                        *(u32x4*)(dst + (size_t)row * ld + cb + bj * 128 + colw) = pack8(a, b); }
                    if (pn == 0) { sq = red_fq(sq); if (fq == 0) B.CQSS[(size_t)row * 4 + wc] = sq; } }
                EPI_FENCE(); }
        } else if (pn == 1) {
            int dq[2][2];
#pragma unroll
            for (int bj = 0; bj < 2; ++bj)
#pragma unroll
                for (int n = 0; n < 2; ++n) dq[bj][n] = head_dq(bj, n, fq);
#pragma unroll
            for (int ai = 0; ai < 2; ++ai) {
#pragma unroll
                for (int mp = 0; mp < 2; ++mp) {
                    float rs2[2]; rs2_load(SS, row0 + ai * 128 + 32 * mp, fq, rs2);
                    f32x4 rc[2], rsn[2]; const int fo = 4 * (fq & 1);
                    if (wc < 2) {
#pragma unroll
                        for (int mm = 0; mm < 2; ++mm) { const float* rp = B.ROPE + (size_t)(row0 + ai * 128 + (2 * mp + mm) * 16) * 16 + fo; rc[mm] = *(const f32x4*)rp; rsn[mm] = *(const f32x4*)(rp + 8); } }
#pragma unroll
                    for (int mm = 0; mm < 2; ++mm) { const int m = 2 * mp + mm, row = row0 + ai * 128 + m * 16;
                        f32x4 v[2][2];
#pragma unroll
                        for (int bj = 0; bj < 2; ++bj)
#pragma unroll
                            for (int n = 0; n < 2; ++n) v[bj][n] = acc[ai][bj][m][n] * rs2[mm];
                        if (wc < 2) {
                            const float hr = head_rs(v);
#pragma unroll
                            for (int bj = 0; bj < 2; ++bj)
#pragma unroll
                                for (int n = 0; n < 2; ++n) v[bj][n] = v[bj][n] * hr * *(const f32x4*)(g_kn + dq[bj][n]);
                            head_rope(v, rc[mm], rsn[mm], fq);
                            head_store16(B.K + (size_t)row * 128 + wc * 64, v, fq);
                        } else {
                            const int tk = row & (SEQ - 1), tkp = (tk & ~12) | ((tk & 4) << 1) | ((tk & 8) >> 1);
                            const unsigned vo = (unsigned)(((row >> 11) * 2 + (wc - 2)) * 64 * SEQ + tkp);
#pragma unroll
                            for (int bj = 0; bj < 2; ++bj)
#pragma unroll
                                for (int n = 0; n < 2; ++n)
#pragma unroll
                                    for (int j = 0; j < 4; ++j) B.VT[vo + (unsigned)((dq[bj][n] + j) * SEQ)] = f2bf(v[bj][n][j]);
                        } }
                    EPI_FENCE(); } }
        } else {
            if (wc == 0) {
                int dq[2][2];
#pragma unroll
                for (int bj = 0; bj < 2; ++bj)
#pragma unroll
                    for (int n = 0; n < 2; ++n) dq[bj][n] = head_dq(bj, n, fq);
#pragma unroll
                for (int ai = 0; ai < 2; ++ai) {
#pragma unroll
                    for (int mp = 0; mp < 2; ++mp) {
                        float rs2[2]; rs2_load(SS, row0 + ai * 128 + 32 * mp, fq, rs2);
                        f32x4 rc[2], rsn[2]; const int fo = 4 * (fq & 1);
#pragma unroll
                        for (int mm = 0; mm < 2; ++mm) { const float* rp = B.ROPE + (size_t)(row0 + ai * 128 + (2 * mp + mm) * 16) * 16 + fo; rc[mm] = *(const f32x4*)rp; rsn[mm] = *(const f32x4*)(rp + 8); }
#pragma unroll
                        for (int mm = 0; mm < 2; ++mm) { const int m = 2 * mp + mm, row = row0 + ai * 128 + m * 16;
                            f32x4 v[2][2];
#pragma unroll
                            for (int bj = 0; bj < 2; ++bj)
#pragma unroll
                                for (int n = 0; n < 2; ++n) v[bj][n] = acc[ai][bj][m][n] * rs2[mm];
                            const float hr = head_rs(v);
#pragma unroll
                            for (int bj = 0; bj < 2; ++bj)
#pragma unroll
                                for (int n = 0; n < 2; ++n) v[bj][n] = v[bj][n] * hr * *(const f32x4*)(g_ik + dq[bj][n]);
                            head_rope(v, rc[mm], rsn[mm], fq);
                            head_store16(B.IK + (size_t)row * 64, v, fq); }
                        EPI_FENCE(); } }
            } else if (wc == 1) {
                const f32x4 ib = *(const f32x4*)i_bias, fb = *(const f32x4*)f_bias;
#pragma unroll
                for (int ai = 0; ai < 2; ++ai) {
                    float rs[4]; rs4_load(SS, row0 + ai * 128, fq, rs);
#pragma unroll
                    for (int m = 0; m < 4; ++m) { const int row = row0 + ai * 128 + m * 16;
                        const f32x4 a = acc[ai][0][m][0] * rs[m], b = acc[ai][0][m][1] * rs[m];
                        if (fq == 0) { *(f32x4*)(B.IW + (size_t)row * 8) = a * IDX_SCALE; *(f32x4*)(B.IW + (size_t)row * 8 + 4) = b * IDX_SCALE; }
                        else if (fq == 1) { *(f32x4*)(B.MI + (size_t)row * 4) = a + ib; f32x4 t = b + fb, o;
#pragma unroll
                            for (int j = 0; j < 4; ++j) o[j] = logsigmoidf_(t[j]);
                            *(f32x4*)(B.MF + (size_t)row * 4) = o; } }
                    EPI_FENCE(); }
            }
        }
    }
};
struct EpiQup {
    Bufs B; const float* g_qn; const int* pos;
    struct Pre {}; __device__ __forceinline__ void prefetch(Pre&, const pg8::Unit&, int, int, int, int) const {}
    __device__ __forceinline__ void operator()(const Acc& acc, const pg8::Unit& u, int wr, int wc, int fr, int fq, const Pre&) const {
        asm volatile("" : "+v"(fr), "+v"(fq));
        const int pn = u.pn, row0 = u.pm * 256 + wr * 64 + fr;
        int dq[2][2];
#pragma unroll
        for (int bj = 0; bj < 2; ++bj)
#pragma unroll
            for (int n = 0; n < 2; ++n) dq[bj][n] = head_dq(bj, n, fq);
        bf16_t* dst = (pn < 2 ? B.Q : B.IQ) + ((pn & 1) * 4 + wc) * 64;
        int pr[8]; float cp[8];
#pragma unroll
        for (int i = 0; i < 8; ++i) { const int row = row0 + (i >> 2) * 128 + (i & 3) * 16; pr[i] = pos[row]; cp[i] = B.CQSS[(size_t)row * 4 + fq]; }
        f32x4 gq[2][2];
#pragma unroll
        for (int bj = 0; bj < 2; ++bj)
#pragma unroll
            for (int n = 0; n < 2; ++n) gq[bj][n] = pn < 2 ? *(const f32x4*)(g_qn + dq[bj][n]) : (f32x4){1.f, 1.f, 1.f, 1.f};
#pragma unroll
        for (int ai = 0; ai < 2; ++ai)
#pragma unroll
            for (int m = 0; m < 4; ++m) { const int i = ai * 4 + m, row = row0 + ai * 128 + m * 16;
                const float rs = rsqrtf(red_fq(cp[i]) * (1.f / 256.f) + EPS);
                f32x4 rc, rsn; rope_quad(pr[i], fq & 1, rc, rsn);
                f32x4 v[2][2];
#pragma unroll
                for (int bj = 0; bj < 2; ++bj)
#pragma unroll
                    for (int n = 0; n < 2; ++n) v[bj][n] = acc[ai][bj][m][n] * rs;
                if (pn < 2) { const float hr = head_rs(v) * QSCALE;
#pragma unroll
                    for (int bj = 0; bj < 2; ++bj)
#pragma unroll
                        for (int n = 0; n < 2; ++n) v[bj][n] = v[bj][n] * hr * gq[bj][n]; }
                head_rope(v, rc, rsn, fq);
                head_store16(dst + (size_t)row * 512, v, fq); }
    }
};

__device__ __forceinline__ int proj_src_col(int n) {
    const int tile = n >> 8, p = n & 255, wc = (p >> 5) & 3, bj = p >> 7, q = p & 31, d = dimmap(bj * 32 + q);
    switch (tile) {
        case 0: return C_CQ + p;
        case 1: return wc < 2 ? C_AK + wc * 64 + d : C_AV + (wc - 2) * 64 + d;
        case 2: case 3: return C_MQ + (tile - 2) * 256 + p;
        case 4: case 5: return C_MK + (tile - 4) * 256 + p;
        case 6: case 7: return C_MV + (tile - 6) * 256 + p;
        case 8: case 9: return C_MO + (tile - 8) * 256 + p;
        default:
            if (wc == 0) return C_IK + d;
            if (wc == 1 && bj == 0) { if (q < 8) return C_IW + q; if (q < 12) return C_MI + q - 8; if (q < 16) return C_MF + q - 12; }
            return -1;
    }
}
__device__ __forceinline__ void prep_item(const float* W, int ldw, int c4, const float* g, bf16_t* Bt, int K, int n0, int k0, LAS float* scr, int lane) {
    f32x4 v[8];
#pragma unroll
    for (int i = 0; i < 8; ++i) { const int kk = 8 * i + (lane >> 3); v[i] = c4 >= 0 ? *(const f32x4*)(W + (size_t)(k0 + kk) * ldw + c4) : (f32x4){0.f, 0.f, 0.f, 0.f}; }
#pragma unroll
    for (int i = 0; i < 8; ++i) { const int kk = 8 * i + (lane >> 3); const float gs = g ? g[k0 + kk] : 1.f; LAS float* d = scr + kk * 33 + 4 * (lane & 7);
        d[0] = v[i][0] * gs; d[1] = v[i][1] * gs; d[2] = v[i][2] * gs; d[3] = v[i][3] * gs; }
    asm volatile("s_waitcnt lgkmcnt(0)" ::: "memory");
    const int cc = lane & 7;
#pragma unroll
    for (int j = 0; j < 4; ++j) { const int n = (lane >> 3) + 8 * j; const LAS float* s = scr + (8 * cc) * 33 + n;
        u32x4 o; o.x = cvt_pk_bf16(s[0 * 33], s[1 * 33]); o.y = cvt_pk_bf16(s[2 * 33], s[3 * 33]); o.z = cvt_pk_bf16(s[4 * 33], s[5 * 33]); o.w = cvt_pk_bf16(s[6 * 33], s[7 * 33]);
        *(u32x4*)(Bt + (size_t)(n0 + n) * K + k0 + 8 * cc) = o; }
    asm volatile("s_waitcnt lgkmcnt(0)" ::: "memory");
}

struct Args {
    const float* in[24]; float* out; unsigned char* ws; int ph_lo, ph_hi, bar_slot, pad;
};

__device__ __forceinline__ void phase_prologue(const Args& a, const Bufs& B, LAS unsigned char* lds, int gw, int NGW, int wave, int lane) {
    LAS float* scr = (LAS float*)(lds + wave * 8704);
    constexpr int I_IN = (DM / 64) * (NPROJ / 32), I_QUP = (QR / 64) * (1024 / 32), I_OUT = (DM / 64) * (DM / 32), I_F1 = (DM / 64) * (DFF / 32), I_F2 = (DFF / 64) * (DM / 32), I_G = I_OUT, I_P = (PLE / 64) * (DM / 32);
    constexpr int I_LAYER = I_IN + I_QUP + I_OUT + I_F1 + I_F2 + I_G + I_P;
    for (int it = gw; it < DEPTH * I_LAYER; it += NGW) {
        const int l = it / I_LAYER; int r = it % I_LAYER;
        unsigned char* wb = a.ws + WS_W + (size_t)l * W_LSTRIDE;
        const int lane31 = 4 * (lane & 7);
        if (r < I_IN) { const int nblk = NPROJ / 32, kb = r / nblk, nb = r % nblk; prep_item(a.in[4] + (size_t)l * DM * IN_W, IN_W, proj_src_col(nb * 32 + lane31), a.in[3] + l * DM, (bf16_t*)(wb + WO_IN), DM, nb * 32, kb * 64, scr, lane); continue; } r -= I_IN;
        if (r < I_QUP) { const int nblk = 32, kb = r / nblk, nb = r % nblk; const int n = nb * 32 + lane31, tile = n >> 8, p = n & 255, wc = (p >> 5) & 3, d = dimmap((p >> 7) * 32 + (p & 31));
            const float* W = (tile < 2 ? a.in[6] : a.in[7]) + (size_t)l * QR * 512;
            prep_item(W, 512, ((tile & 1) * 4 + wc) * 64 + d, a.in[5] + l * QR, (bf16_t*)(wb + WO_QUP), QR, nb * 32, kb * 64, scr, lane); continue; } r -= I_QUP;
        if (r < I_OUT) { const int nblk = DM / 32, kb = r / nblk, nb = r % nblk; prep_item(a.in[16] + (size_t)l * DM * DM, DM, nb * 32 + lane31, nullptr, (bf16_t*)(wb + WO_OUT), DM, nb * 32, kb * 64, scr, lane); continue; } r -= I_OUT;
        if (r < I_F1) { const int nblk = DFF / 32, kb = r / nblk, nb = r % nblk; prep_item(a.in[18] + (size_t)l * DM * DFF, DFF, nb * 32 + lane31, a.in[17] + l * DM, (bf16_t*)(wb + WO_F1), DM, nb * 32, kb * 64, scr, lane); continue; } r -= I_F1;
        if (r < I_F2) { const int nblk = DM / 32, kb = r / nblk, nb = r % nblk; prep_item(a.in[19] + (size_t)l * DFF * DM, DM, nb * 32 + lane31, nullptr, (bf16_t*)(wb + WO_F2), DFF, nb * 32, kb * 64, scr, lane); continue; } r -= I_F2;
        if (r < I_G) { const int nblk = DM / 32, kb = r / nblk, nb = r % nblk; prep_item(a.in[21] + (size_t)l * DM * DM, DM, nb * 32 + lane31, a.in[20] + l * DM, (bf16_t*)(wb + WO_G), DM, nb * 32, kb * 64, scr, lane); continue; } r -= I_G;
        { const int nblk = DM / 32, kb = r / nblk, nb = r % nblk; prep_item(a.in[23] + (size_t)l * PLE * DM, DM, nb * 32 + lane31, nullptr, (bf16_t*)(wb + WO_P), PLE, nb * 32, kb * 64, scr, lane); }
    }
    const float* x = a.in[0];
    for (int row0 = gw * 4; row0 < M; row0 += NGW * 4) {
        f32x4 v[4][4];
#pragma unroll
        for (int r = 0; r < 4; ++r) { const f32x4* xr = (const f32x4*)(x + (size_t)(row0 + r) * DM) + lane;
#pragma unroll
            for (int j = 0; j < 4; ++j) v[r][j] = xr[64 * j]; }
#pragma unroll
        for (int r = 0; r < 4; ++r) { float s = 0.f; u32x2* o = (u32x2*)((bf16_t*)a.out + (size_t)(row0 + r) * DM) + lane;
#pragma unroll
            for (int j = 0; j < 4; ++j) { s += dot4(v[r][j]); o[64 * j] = pack4(v[r][j]); }
            s = wave_sum(s);
            if (lane < 16) B.SS[(size_t)(row0 + r) * 16 + lane] = lane == 0 ? s : 0.f; }
    }
    const int* pos = (const int*)a.in[2];
    for (int i = gw * 64 + lane; i < M * 8; i += NGW * 64) {
        const int row = i >> 3, f = i & 7;
        const float inv = exp2f(-(float)f * (18.931568569324174f / 8.f));
        const float ang = (float)pos[row] * inv;
        const double rev = (double)ang * 0.15915494309189535; const float fr = (float)(rev - rint(rev));
        B.ROPE[row * 16 + f] = __builtin_amdgcn_cosf(fr); B.ROPE[row * 16 + 8 + f] = __builtin_amdgcn_sinf(fr);
    }
    const f32x4* p4 = (const f32x4*)a.in[1]; u32x2* pb = (u32x2*)B.PB;
#pragma unroll 4
    for (size_t i = (size_t)gw * 64 + lane; i < (size_t)DEPTH * M * PLE / 4; i += (size_t)NGW * 64) pb[i] = pack4(p4[i]);
}

typedef float f32x16 __attribute__((ext_vector_type(16)));
__device__ __forceinline__ unsigned half_sum_u(unsigned v) {
#pragma unroll
    for (int o = 1; o < 32; o <<= 1) v += (unsigned)__shfl_xor((int)v, o);
    return v;
}
__device__ __forceinline__ unsigned half_sum_dpp(unsigned v, int hf) {
    v += (unsigned)__builtin_amdgcn_update_dpp(0, (int)v, 0xB1, 0xf, 0xf, false);
    v += (unsigned)__builtin_amdgcn_update_dpp(0, (int)v, 0x4E, 0xf, 0xf, false);
    v += (unsigned)__builtin_amdgcn_update_dpp(0, (int)v, 0x141, 0xf, 0xf, false);
    v += (unsigned)__builtin_amdgcn_update_dpp(0, (int)v, 0x140, 0xf, 0xf, false);
    const unsigned s0 = (unsigned)__builtin_amdgcn_readlane((int)v, 0), s1 = (unsigned)__builtin_amdgcn_readlane((int)v, 16), s2 = (unsigned)__builtin_amdgcn_readlane((int)v, 32), s3 = (unsigned)__builtin_amdgcn_readlane((int)v, 48);
    return hf ? s2 + s3 : s0 + s1;
}
struct IdxPre { bf16x8 af0, af1; f32x4 w; u32x4 g0[4]; };
__device__ __forceinline__ void idx_preload(IdxPre& P, const Bufs& B, int b, int qb, int wave, int lane) {
    const int hf = lane >> 5, l15 = lane & 15, q4 = lane >> 4, tid = wave * 64 + lane;
    const int q0w = qb * 16 + 2 * wave, q = q0w + hf; const size_t rowb = (size_t)b * SEQ;
    const bf16_t* aqb = B.IQ + rowb * 512; const unsigned ao = (unsigned)((q0w + (l15 >> 3)) * 512 + (l15 & 7) * 64 + 8 * q4);
    P.af0 = *(const bf16x8*)(aqb + ao); P.af1 = *(const bf16x8*)(aqb + (ao + 32u));
    P.w = *(const f32x4*)(B.IW + rowb * 8 + (unsigned)q * 8u + 4u * (unsigned)(q4 & 1));
    const bf16_t* kb = B.IK + rowb * 64;
#pragma unroll
    for (int i = 0; i < 4; ++i) P.g0[i] = *(const u32x4*)(kb + ((unsigned)tid * 8u + (unsigned)i * 4096u));
}
__device__ __forceinline__ int idx_wg_item(const Bufs& B, LAS unsigned char* lds, int b, int qb, int wave, int lane, const IdxPre& P, IdxPre& Pn, volatile LAS int* slotn, bool ldr, int nxt, int dsh, int bb) {
    { unsigned m1 = ~0u; asm volatile("" : "+s"(m1)); lane = (int)__builtin_amdgcn_mbcnt_hi(m1, __builtin_amdgcn_mbcnt_lo(m1, 0u)); }
    const int hf = lane >> 5, l31 = lane & 31, l15 = lane & 15, q4 = lane >> 4, tid = wave * 64 + lane;
    const int q0w = qb * 16 + 2 * wave;
    const int nt = ((qb * 16 + 15) >> 5) + 1, ng = (nt + 7) >> 3;
    const size_t rowb = (size_t)b * SEQ;
    const int q = q0w + hf;
    const bf16x8 af0 = P.af0, af1 = P.af1;
    float w4[4];
#pragma unroll
    for (int j = 0; j < 4; ++j) w4[j] = P.w[j];
    const bf16_t* kb = B.IK + rowb * 64;
    const int sd0 = (tid >> 3) * 128 + (((tid & 7) ^ ((tid >> 3) & 7)) << 4);
    int roff[2][2];
#pragma unroll
    for (int th = 0; th < 2; ++th)
#pragma unroll
        for (int ks = 0; ks < 2; ++ks) roff[th][ks] = (16 * th + l15) * 128 + (((4 * ks + q4) ^ (l15 & 7)) << 4);
    unsigned sc[64];
    u32x4 pre[4], nx2[4];
    unsigned go = (unsigned)tid * 8u;
    asm volatile("" : "+v"(go));
#pragma unroll
    for (int i = 0; i < 4; ++i) pre[i] = P.g0[i];
    __syncthreads();
#pragma unroll
    for (int i = 0; i < 4; ++i) *(LAS u32x4*)(lds + sd0 + i * 8192) = pre[i];
    if (ng > 1) { go += 256u * 64u; asm volatile("" : "+v"(go));
#pragma unroll
        for (int i = 0; i < 4; ++i) pre[i] = *(const u32x4*)(kb + (go + (unsigned)i * 4096u)); }
    __syncthreads();
#pragma unroll
    for (int g = 0; g < 8; ++g) {
        if (g < ng) {
            if (g + 2 < ng) {
                go += 256u * 64u; asm volatile("" : "+v"(go));
#pragma unroll
                for (int i = 0; i < 4; ++i) nx2[i] = *(const u32x4*)(kb + (go + (unsigned)i * 4096u)); }
            const LAS unsigned char* buf = lds + (g % 3) * 32768;
            bf16x8 fr[4], fn[4];
            fr[0] = *(const LAS bf16x8*)(buf + roff[0][0]); fr[1] = *(const LAS bf16x8*)(buf + roff[1][0]); fr[2] = *(const LAS bf16x8*)(buf + roff[0][1]); fr[3] = *(const LAS bf16x8*)(buf + roff[1][1]);
            float own_p = 0.f, rcv_p = 0.f;
#pragma unroll
            for (int tt = 0; tt < 8; ++tt) { const int t = g * 8 + tt;
                if (tt < 7) { fn[0] = *(const LAS bf16x8*)(buf + (tt + 1) * 4096 + roff[0][0]); fn[1] = *(const LAS bf16x8*)(buf + (tt + 1) * 4096 + roff[1][0]);
                              fn[2] = *(const LAS bf16x8*)(buf + (tt + 1) * 4096 + roff[0][1]); fn[3] = *(const LAS bf16x8*)(buf + (tt + 1) * 4096 + roff[1][1]); }
                f32x4 a0 = {0.f, 0.f, 0.f, 0.f}, a1 = {0.f, 0.f, 0.f, 0.f};
                a0 = __builtin_amdgcn_mfma_f32_16x16x32_bf16(af0, fr[0], a0, 0, 0, 0);
                a1 = __builtin_amdgcn_mfma_f32_16x16x32_bf16(af0, fr[1], a1, 0, 0, 0);
                a0 = __builtin_amdgcn_mfma_f32_16x16x32_bf16(af1, fr[2], a0, 0, 0, 0);
                a1 = __builtin_amdgcn_mfma_f32_16x16x32_bf16(af1, fr[3], a1, 0, 0, 0);
                if (tt > 0) { const float s = own_p + rcv_p; const unsigned vm = (unsigned)-(int)(((t - 1) * 32 + l31) <= q); sc[t - 1] = f2ord(s + 0.f) & vm; }
                float p0, p1;
#pragma unroll
                for (int r = 0; r < 4; ++r) {
                    const float x0 = __int_as_float(max(__float_as_int(a0[r]), 0)), x1 = __int_as_float(max(__float_as_int(a1[r]), 0));
                    if (r == 0) { asm("v_mul_f32 %0, %1, %2" : "=v"(p0) : "v"(w4[0]), "v"(x0)); asm("v_mul_f32 %0, %1, %2" : "=v"(p1) : "v"(w4[0]), "v"(x1)); }
                    else { asm("v_fma_f32 %0, %1, %2, %0" : "+v"(p0) : "v"(w4[r]), "v"(x0)); asm("v_fma_f32 %0, %1, %2, %0" : "+v"(p1) : "v"(w4[r]), "v"(x1)); } }
                const float snd = (q4 & 1) ? p0 : p1;
                rcv_p = __int_as_float(__builtin_amdgcn_ds_swizzle(__float_as_int(snd), 0x401F));
                own_p = (q4 & 1) ? p1 : p0;
#pragma unroll
                for (int i = 0; i < 4; ++i) fr[i] = fn[i];
            }
            { const int t = g * 8 + 7; const float s = own_p + rcv_p; const unsigned vm = (unsigned)-(int)((t * 32 + l31) <= q); sc[t] = f2ord(s + 0.f) & vm; }
            if (g + 1 < ng) {
#pragma unroll
                for (int i = 0; i < 4; ++i) *(LAS u32x4*)(lds + ((g + 1) % 3) * 32768 + sd0 + i * 8192) = pre[i]; }
#pragma unroll
            for (int i = 0; i < 4; ++i) pre[i] = nx2[i];
            __syncthreads();
        } else {
#pragma unroll
            for (int tt = 0; tt < 8; ++tt) sc[g * 8 + tt] = 0u;
        }
    }
    int itn;
    { if (ldr) slotn[0] = nxt; __syncthreads(); itn = __builtin_amdgcn_readfirstlane(slotn[0]); if (itn < (128 << dsh)) idx_preload(Pn, B, bb + (itn & ((1 << dsh) - 1)), 127 - (itn >> dsh), wave, lane); }
    const bool need = q + 1 > TOPK;
    unsigned Pth = 0u, r_take = 0u;
    if (__any(need)) {
        unsigned prefix = 0u, cge = 0xffffffffu, nhi = 0u; bool done = !need; int bit = 31;
#pragma unroll 1
        for (; bit >= 0; --bit) {
            if (!__any(!done && (cge - nhi > 32u))) break;
            const unsigned cand = prefix | (1u << bit);
            unsigned c0 = 0u, c1 = 0u;
#pragma unroll
            for (int t8 = 0; t8 < 8; ++t8) if (t8 < ng) {
#pragma unroll
                for (int tt = 0; tt < 8; tt += 4) {
                    unsigned long long m0, m1, m2, m3;
                    asm("v_cmp_ge_u32_e64 %[m0], %[x0], %[cd]\n\tv_cmp_ge_u32_e64 %[m1], %[x1], %[cd]\n\tv_cmp_ge_u32_e64 %[m2], %[x2], %[cd]\n\tv_cmp_ge_u32_e64 %[m3], %[x3], %[cd]\n\t"
                        "v_addc_co_u32_e64 %[c0], vcc, 0, %[c0], %[m0]\n\tv_addc_co_u32_e64 %[c1], vcc, 0, %[c1], %[m1]\n\tv_addc_co_u32_e64 %[c0], vcc, 0, %[c0], %[m2]\n\tv_addc_co_u32_e64 %[c1], vcc, 0, %[c1], %[m3]"
                        : [c0] "+v"(c0), [c1] "+v"(c1), [m0] "=&s"(m0), [m1] "=&s"(m1), [m2] "=&s"(m2), [m3] "=&s"(m3)
                        : [x0] "v"(sc[t8 * 8 + tt]), [x1] "v"(sc[t8 * 8 + tt + 1]), [x2] "v"(sc[t8 * 8 + tt + 2]), [x3] "v"(sc[t8 * 8 + tt + 3]), [cd] "v"(cand) : "vcc"); } }
            const unsigned c = half_sum_dpp(c0 + c1, hf);
            if (!done) { if (c >= (unsigned)TOPK) { prefix = cand; cge = c; } else nhi = c; if (c == (unsigned)TOPK) { done = true; Pth = cand - 1u; } }
        }
        if (__any(!done)) {
            int hfl = hf; asm volatile("" : "+v"(hfl));
            LAS unsigned* lst = (LAS unsigned*)(lds + 98304) + (wave * 2 + hfl) * 32;
            const int sh = bit + 1;
            unsigned base = 0u;
#pragma unroll
            for (int t8 = 0; t8 < 8; ++t8) if (t8 < ng) {
#pragma unroll
                for (int tt = 0; tt < 8; ++tt) { const unsigned v = sc[t8 * 8 + tt];
                    const bool fl = !done && v != 0u && ((v ^ prefix) >> sh) == 0u;
                    const unsigned long long bm = __ballot(fl); const unsigned mh = hf ? (unsigned)(bm >> 32) : (unsigned)bm;
                    const unsigned pos = base + __popc(mh & ((1u << l31) - 1u));
                    if (fl && pos < 32u) lst[pos] = v;
                    base += __popc(mh); } }
            const unsigned cv = (unsigned)l31 < base ? lst[l31] : 0u;
#pragma unroll 1
            for (; bit >= 0; --bit) {
                if (__all(done)) break;
                const unsigned cand = prefix | (1u << bit);
                const unsigned long long bm = __ballot(cv >= cand); const unsigned c = nhi + __popc(hf ? (unsigned)(bm >> 32) : (unsigned)bm);
                if (!done) { if (c >= (unsigned)TOPK) prefix = cand; if (c == (unsigned)TOPK) { done = true; Pth = cand - 1u; } }
            }
            const bool tie = need && !done;
            if (__any(tie)) {
                const unsigned long long bm = __ballot(cv > prefix); const unsigned c = nhi + __popc(hf ? (unsigned)(bm >> 32) : (unsigned)bm);
                if (tie) { Pth = prefix; r_take = (unsigned)TOPK - c; }
            }
        }
    }
    const bool anytie = __any(r_take > 0u);
    unsigned taken = 0u;
    unsigned* sob = B.SEL + rowb * 64; const unsigned soo = (unsigned)q * 64u;
    int hfw = hf; asm volatile("" : "+v"(hfw));
    LAS unsigned* wl = (LAS unsigned*)(lds + 98304 + 2048) + (wave * 2 + hfw) * 64;
#pragma unroll
    for (int t = 0; t < 64; ++t) {
        unsigned wsel = 0u;
        if ((t >> 3) < ng) {
            const unsigned v = sc[t];
            bool sel = v > Pth;
            if (anytie) {
                const bool eq = (v == Pth) && (r_take > 0u);
                const unsigned long long bm = __ballot(eq); const unsigned mh = hf ? (unsigned)(bm >> 32) : (unsigned)bm;
                const unsigned below = __popc(mh & ((1u << l31) - 1u));
                sel = sel || (eq && (taken + below < r_take));
                taken += __popc(mh);
            }
            const unsigned long long sm = __ballot(sel);
            wsel = hf ? (unsigned)(sm >> 32) : (unsigned)sm;
        }
        if (l31 == 0) wl[t] = wsel;
    }
    sob[soo + (unsigned)l31] = wl[l31]; sob[soo + 32u + (unsigned)l31] = wl[32 + l31];
    return itn;
}
constexpr int AT_KB = 0, AT_VB = 49152, AT_SEL = 98304, AT_END = 114688;
__device__ __forceinline__ unsigned cvt_pk_bf16_nv(float lo, float hi) { unsigned r; asm("v_cvt_pk_bf16_f32 %0, %1, %2" : "=v"(r) : "v"(lo), "v"(hi)); return r; }
template <int G, bool HAS_QK, bool HAS_PV>
__device__ __forceinline__ void att_group(f32x16& Sc, const unsigned mw, float& ps, unsigned (&w)[8], f32x16& Sn, const bf16x8 (&kfn)[4], const bf16x8 (&qfn)[4],
                                          f32x16 (&oa)[2], const bf16x8 (&vf)[2][2], const bf16x8 (&pbp)[2]) {
    if constexpr (HAS_QK && G < 4) {
        if constexpr (G == 0) { const f32x16 z = {0.f, 0.f, 0.f, 0.f, 0.f, 0.f, 0.f, 0.f, 0.f, 0.f, 0.f, 0.f, 0.f, 0.f, 0.f, 0.f}; Sn = __builtin_amdgcn_mfma_f32_32x32x16_bf16(kfn[0], qfn[0], z, 0, 0, 0); }
        else Sn = __builtin_amdgcn_mfma_f32_32x32x16_bf16(kfn[G], qfn[G], Sn, 0, 0, 0);
        asm volatile("" : "+v"(Sn));
    }
    if constexpr (HAS_PV && G >= 4) { oa[(G - 4) >> 1] = __builtin_amdgcn_mfma_f32_32x32x16_bf16(vf[(G - 4) >> 1][(G - 4) & 1], pbp[(G - 4) & 1], oa[(G - 4) >> 1], 0, 0, 0);
        asm volatile("" : "+v"(oa[(G - 4) >> 1])); }
    constexpr int R = 2 * G;
    asm volatile("" : "+v"(Sc));
    float x0 = Sc[R], x1 = Sc[R + 1];
    const float e0 = __builtin_amdgcn_exp2f(x0), e1 = __builtin_amdgcn_exp2f(x1); int m0, m1;
    asm("v_bfe_i32 %0, %1, %2, 1" : "=v"(m0) : "v"(mw), "n"((R & 3) + 8 * (R >> 2)));
    asm("v_bfe_i32 %0, %1, %2, 1" : "=v"(m1) : "v"(mw), "n"(((R + 1) & 3) + 8 * ((R + 1) >> 2)));
    const float p0 = __int_as_float(__float_as_int(e0) & m0), p1 = __int_as_float(__float_as_int(e1) & m1);
    ps += p0 + p1; asm volatile("" : "+v"(ps));
    w[G] = cvt_pk_bf16_nv(p0, p1);
    __builtin_amdgcn_sched_barrier(0);
}
template <bool HAS_QK, bool HAS_PV>
__device__ __forceinline__ void att_step(f32x16& Sc, const unsigned mw, float& lsum, bf16x8 (&pbo)[2], f32x16& Sn, const bf16x8 (&kfn)[4], const bf16x8 (&qfn)[4],
                                         f32x16 (&oa)[2], const bf16x8 (&vf)[2][2], const bf16x8 (&pbp)[2]) {
    unsigned w[8]; float ps = 0.f;
    __builtin_amdgcn_sched_barrier(0);
    att_group<0, HAS_QK, HAS_PV>(Sc, mw, ps, w, Sn, kfn, qfn, oa, vf, pbp); att_group<1, HAS_QK, HAS_PV>(Sc, mw, ps, w, Sn, kfn, qfn, oa, vf, pbp);
    att_group<2, HAS_QK, HAS_PV>(Sc, mw, ps, w, Sn, kfn, qfn, oa, vf, pbp); att_group<3, HAS_QK, HAS_PV>(Sc, mw, ps, w, Sn, kfn, qfn, oa, vf, pbp);
    att_group<4, HAS_QK, HAS_PV>(Sc, mw, ps, w, Sn, kfn, qfn, oa, vf, pbp); att_group<5, HAS_QK, HAS_PV>(Sc, mw, ps, w, Sn, kfn, qfn, oa, vf, pbp);
    att_group<6, HAS_QK, HAS_PV>(Sc, mw, ps, w, Sn, kfn, qfn, oa, vf, pbp); att_group<7, HAS_QK, HAS_PV>(Sc, mw, ps, w, Sn, kfn, qfn, oa, vf, pbp);
    lsum += ps;
    u32x4 x0, x1; x0.x = w[0]; x0.y = w[1]; x0.z = w[2]; x0.w = w[3]; x1.x = w[4]; x1.y = w[5]; x1.z = w[6]; x1.w = w[7];
    pbo[0] = __builtin_bit_cast(bf16x8, x0); pbo[1] = __builtin_bit_cast(bf16x8, x1);
}
__device__ __forceinline__ void att_wg_item(const Bufs& B, LAS unsigned char* lds, int b, int qb, int wave, int lane) {
    { unsigned m1 = ~0u; asm volatile("" : "+s"(m1)); lane = (int)__builtin_amdgcn_mbcnt_hi(m1, __builtin_amdgcn_mbcnt_lo(m1, 0u)); }
    const int hf = lane >> 5, l31 = lane & 31, tid = wave * 64 + lane, wv = __builtin_amdgcn_readfirstlane(wave);
    const int g = wave & 1, q0 = qb * 64, qa = q0 + 16 * (wave >> 1);
    const int ns = qb + 1;
    const size_t rowb = (size_t)b * SEQ;
    const bf16_t* kbase = B.K + rowb * 128; const bf16_t* vbase = B.VT + (size_t)b * 128 * SEQ;
    unsigned ksrc[2], vsrc[2];
#pragma unroll
    for (int i = 0; i < 2; ++i) { const int p = tid + 512 * i;
        { const int row = p >> 4, ss = p & 15; ksrc[i] = (unsigned)(row * 256 + ((ss ^ (row & 7)) << 4)); }
        { const int row = p >> 3, ss = p & 7; vsrc[i] = (unsigned)(row * (SEQ * 2) + ((ss ^ ((row >> 1) & 7)) << 4)); } }
#define ATT_DMA(slot_, ko_, vo_) do { _Pragma("unroll") for (int _i = 0; _i < 2; ++_i) { \
        __builtin_amdgcn_global_load_lds((const unsigned*)(((const char*)kbase + (ko_)) + ksrc[_i]), (LAS unsigned*)(lds + AT_KB + (slot_) * 16384 + _i * 8192 + wv * 1024), 16, 0, 0); \
        __builtin_amdgcn_global_load_lds((const unsigned*)(((const char*)vbase + (vo_)) + vsrc[_i]), (LAS unsigned*)(lds + AT_VB + (slot_) * 16384 + _i * 8192 + wv * 1024), 16, 0, 0); } } while (0)
    __syncthreads();
    ATT_DMA(0, 0u, 0u);
    if (ns > 1) ATT_DMA(1, 64u * 256u, 128u);
    { const unsigned* sb = B.SEL + (rowb + q0) * 64;
#pragma unroll
      for (int i = 0; i < 2; ++i) *(LAS u32x4*)(lds + AT_SEL + (tid + 512 * i) * 16) = *(const u32x4*)(sb + (tid + 512 * i) * 4); }
    bf16x8 qf[2][4];
    { const bf16_t* qbase = B.Q + rowb * 512;
#pragma unroll
      for (int c2 = 0; c2 < 2; ++c2) { const unsigned qo = (unsigned)((qa + 8 * c2 + (l31 >> 2)) * 512 + (4 * g + (l31 & 3)) * 64 + 8 * hf);
#pragma unroll
        for (int ks = 0; ks < 4; ++ks) qf[c2][ks] = *(const bf16x8*)(qbase + (qo + 16u * ks)); } }
    f32x16 o[2][2]; float lsum[2] = {0.f, 0.f};
#pragma unroll
    for (int c2 = 0; c2 < 2; ++c2)
#pragma unroll
        for (int dt = 0; dt < 2; ++dt)
#pragma unroll
            for (int r = 0; r < 16; ++r) o[c2][dt][r] = 0.f;
    unsigned koff = 64u * 256u, voff = 128u;
    if (ns > 1) asm volatile("s_waitcnt vmcnt(4)" ::: "memory"); else asm volatile("s_waitcnt vmcnt(0)" ::: "memory");
    __syncthreads();
    int kro[4];
#pragma unroll
    for (int ks = 0; ks < 4; ++ks) kro[ks] = l31 * 256 + (((g * 8 + 2 * ks + hf) ^ (l31 & 7)) << 4);
    const int selo = AT_SEL + ((16 * (wave >> 1) + (l31 >> 2)) * 64) * 4;
    int cur = 0;
#pragma unroll 1
    for (int st = 0; st < ns; ++st) {
        const int nx2 = cur == 0 ? 2 : cur - 1;
        if (st + 2 < ns) { koff += 64u * 256u; voff += 128u; asm volatile("" : "+s"(koff), "+s"(voff)); ATT_DMA(nx2, koff, voff); }
        const LAS unsigned char* kb = lds + AT_KB + cur * 16384; const LAS unsigned char* vb = lds + AT_VB + cur * 16384;
        {
            bf16x8 kf0[4], kf1[4], vfa[2][2], vfb[2][2], pbA[2], pbB[2]; f32x16 Sa, Sb;
#pragma unroll
            for (int ks = 0; ks < 4; ++ks) kf0[ks] = *(const LAS bf16x8*)(kb + kro[ks]);
            const LAS unsigned* swp = (const LAS unsigned*)(lds + selo + st * 8);
            const unsigned mw00 = swp[0] >> (4 * hf), mw10 = swp[1] >> (4 * hf), mw01 = swp[8 * 64] >> (4 * hf), mw11 = swp[8 * 64 + 1] >> (4 * hf);
            { const f32x16 z = {0.f, 0.f, 0.f, 0.f, 0.f, 0.f, 0.f, 0.f, 0.f, 0.f, 0.f, 0.f, 0.f, 0.f, 0.f, 0.f};
              Sa = __builtin_amdgcn_mfma_f32_32x32x16_bf16(kf0[0], qf[0][0], z, 0, 0, 0);
#pragma unroll
              for (int ks = 1; ks < 4; ++ks) Sa = __builtin_amdgcn_mfma_f32_32x32x16_bf16(kf0[ks], qf[0][ks], Sa, 0, 0, 0); }
#pragma unroll
            for (int ks = 0; ks < 4; ++ks) kf1[ks] = *(const LAS bf16x8*)(kb + 8192 + kro[ks]);
            att_step<true, false>(Sa, mw00, lsum[0], pbA, Sb, kf0, qf[1], o[0], vfa, pbA);
#pragma unroll
            for (int dt = 0; dt < 2; ++dt) { const int row = g * 64 + 32 * dt + l31; const LAS unsigned char* vr = vb + row * 128; const int sw = (row >> 1) & 7;
#pragma unroll
                for (int s = 0; s < 2; ++s) vfa[dt][s] = *(const LAS bf16x8*)(vr + (((2 * s + hf) ^ sw) << 4)); }
            att_step<true, true>(Sb, mw01, lsum[1], pbB, Sa, kf1, qf[0], o[0], vfa, pbA);
            att_step<true, true>(Sa, mw10, lsum[0], pbA, Sb, kf1, qf[1], o[1], vfa, pbB);
#pragma unroll
            for (int dt = 0; dt < 2; ++dt) { const int row = g * 64 + 32 * dt + l31; const LAS unsigned char* vr = vb + row * 128; const int sw = (row >> 1) & 7;
#pragma unroll
                for (int s = 0; s < 2; ++s) vfb[dt][s] = *(const LAS bf16x8*)(vr + (((4 + 2 * s + hf) ^ sw) << 4)); }
            att_step<false, true>(Sb, mw11, lsum[1], pbB, Sa, kf1, qf[1], o[0], vfb, pbA);
#pragma unroll
            for (int dt = 0; dt < 2; ++dt)
#pragma unroll
                for (int s = 0; s < 2; ++s) o[1][dt] = __builtin_amdgcn_mfma_f32_32x32x16_bf16(vfb[dt][s], pbB[s], o[1][dt], 0, 0, 0);
        }
        if (st + 2 < ns) asm volatile("s_waitcnt vmcnt(4)" ::: "memory"); else asm volatile("s_waitcnt vmcnt(0)" ::: "memory");
        asm volatile("s_waitcnt lgkmcnt(0)" ::: "memory");
        __builtin_amdgcn_s_barrier();
        cur = cur == 2 ? 0 : cur + 1;
    }
#undef ATT_DMA
    { unsigned m1 = ~0u; asm volatile("" : "+s"(m1)); const int ln = (int)__builtin_amdgcn_mbcnt_hi(m1, __builtin_amdgcn_mbcnt_lo(m1, 0u));
      bf16_t* ob = B.MIX + rowb * 1024;
#pragma unroll
      for (int c2 = 0; c2 < 2; ++c2) {
        const float l = lsum[c2] + __int_as_float(__builtin_amdgcn_ds_bpermute((ln ^ 32) << 2, __float_as_int(lsum[c2]))); const float inv = __builtin_amdgcn_rcpf(l);
        const unsigned oo = (unsigned)((qa + 8 * c2 + ((ln & 31) >> 2)) * 1024 + (4 * g + (ln & 3)) * 64 + 4 * (ln >> 5));
#pragma unroll
        for (int dt = 0; dt < 2; ++dt)
#pragma unroll
            for (int rr = 0; rr < 4; ++rr) { f32x4 v; v[0] = o[c2][dt][4 * rr] * inv; v[1] = o[c2][dt][4 * rr + 1] * inv; v[2] = o[c2][dt][4 * rr + 2] * inv; v[3] = o[c2][dt][4 * rr + 3] * inv;
                *(u32x2*)(ob + (oo + (unsigned)(32 * dt + 8 * rr))) = pack4(v); }
      } }
}

#define XB_TMO      128
#define XB_XCNT(j)  (256  + 64 * (j))
#define XB_XSUB(j)  (1280 + 64 * (j))
#define XB_XGEN(j)  (2304 + 64 * (j))
#define XB_TOP      3328
#define XB_TOPGEN   3392
#define XCD_BAR_WORDS 3456
#define XB_SPIN_CAP (1u << 22)
__device__ __forceinline__ unsigned xb_ld(unsigned* p)              { return __hip_atomic_load(p, __ATOMIC_RELAXED, __HIP_MEMORY_SCOPE_AGENT); }
__device__ __forceinline__ unsigned xb_add(unsigned* p, unsigned v) { return __hip_atomic_fetch_add(p, v, __ATOMIC_RELAXED, __HIP_MEMORY_SCOPE_AGENT); }
__device__ __forceinline__ unsigned xb_xcc_id() { return (unsigned)__builtin_amdgcn_s_getreg((3 << 11) | 20) & 0xFu; }
#define XB_SPIN(cond, bar) do { unsigned _sp = 0; while (cond) { __builtin_amdgcn_s_sleep(1); \
    if ((++_sp & 255u) == 0u) { if (xb_ld(&(bar)[XB_TMO])) break; if (_sp > XB_SPIN_CAP) { atomicAdd(&(bar)[XB_TMO], 1u); break; } } } } while (0)
struct XcdBarrier { unsigned* bar; unsigned x; volatile LAS unsigned* st; };
__device__ __forceinline__ XcdBarrier xcd_barrier_post(unsigned* bar, volatile LAS unsigned* st, bool leader) {
    XcdBarrier b; b.bar = bar; b.x = xb_xcc_id(); b.st = st;
    if (leader) (void)xb_add(&bar[XB_XCNT(b.x)], 1u);
    return b;
}
__device__ __forceinline__ void xcd_barrier_complete(unsigned* bar, unsigned x, unsigned& nloc, unsigned& nx) {
    const unsigned G = gridDim.x;
    unsigned sum, cnt, mine, sp = 0u;
    for (;;) {
        sum = 0u; cnt = 0u; mine = 0u;
#pragma unroll
        for (unsigned j = 0; j < 16; ++j) { const unsigned c = xb_ld(&bar[XB_XCNT(j)]); sum += c; cnt += (c > 0u) ? 1u : 0u; mine = (j == x) ? c : mine; }
        if (sum == G) break;
        __builtin_amdgcn_s_sleep(1);
        if ((++sp & 255u) == 0u) { if (xb_ld(&bar[XB_TMO])) break; if (sp > XB_SPIN_CAP) { atomicAdd(&bar[XB_TMO], 1u); break; } }
    }
    nloc = mine > 0u ? mine : 1u; nx = cnt > 0u ? cnt : 1u;
}
__device__ __forceinline__ void xcd_barrier(const XcdBarrier& b, bool leader) {
    asm volatile("s_waitcnt vmcnt(0)" ::: "memory");
    __syncthreads();
    if (leader) {
        unsigned* bar = b.bar;
        __builtin_amdgcn_s_waitcnt(0);
        unsigned nloc = b.st[0], nx = b.st[1];
        if (nloc == 0u) { xcd_barrier_complete(bar, b.x, nloc, nx); b.st[0] = nloc; b.st[1] = nx; }
        const unsigned old = xb_add(&bar[XB_XSUB(b.x)], 1u);
        const unsigned gen = old / nloc;
        if (old + 1u == (gen + 1u) * nloc) {
            __builtin_amdgcn_fence(__ATOMIC_RELEASE, "agent");
            asm volatile("s_waitcnt vmcnt(0)" ::: "memory");
            const unsigned og = xb_add(&bar[XB_TOP], 1u);
            const unsigned tg = og / nx;
            if (og + 1u == (tg + 1u) * nx) xb_add(&bar[XB_TOPGEN], 1u);
            else XB_SPIN(xb_ld(&bar[XB_TOPGEN]) == tg, bar);
            __builtin_amdgcn_fence(__ATOMIC_ACQUIRE, "agent");
            xb_add(&bar[XB_XGEN(b.x)], 1u);
            asm volatile("s_waitcnt vmcnt(0)" ::: "memory");
        } else {
            XB_SPIN(xb_ld(&bar[XB_XGEN(b.x)]) == gen, bar);
            __builtin_amdgcn_fence(__ATOMIC_ACQUIRE, "agent");
            asm volatile("s_waitcnt vmcnt(0)" ::: "memory");
        }
    }
    __syncthreads();
}
constexpr int GB_CNT = 230000, GB_XID = 231000;
constexpr int GW_CNT0 = 232000;
__device__ __forceinline__ void grp_barrier(unsigned* ctl, const XcdBarrier& bar, const unsigned mode, const unsigned gen, bool leader, const int arrive = -1, const int wait = -1) {
    asm volatile("s_waitcnt vmcnt(0)" ::: "memory");
    __syncthreads();
    if (leader) {
        unsigned* cnt = ctl + GB_CNT + 64 * (blockIdx.x & 7);
        if (!(mode & 2u)) { __builtin_amdgcn_fence(__ATOMIC_RELEASE, "agent"); asm volatile("s_waitcnt vmcnt(0)" ::: "memory"); }
        __builtin_amdgcn_s_waitcnt(0);
        if (arrive >= 0) (void)xb_add(ctl + GW_CNT0 + 64 * arrive, 1u);
        (void)xb_add(cnt, 1u);
        const unsigned target = 32u * gen;
        XB_SPIN(xb_ld(cnt) < target, bar.bar);
        if (wait >= 0) { unsigned* wc = ctl + GW_CNT0 + 64 * wait; XB_SPIN(xb_ld(wc) < gridDim.x, bar.bar); }
        __builtin_amdgcn_fence(__ATOMIC_ACQUIRE, "agent");
        asm volatile("s_waitcnt vmcnt(0)" ::: "memory");
    }
    __syncthreads();
}

typedef float f32x4v __attribute__((ext_vector_type(4)));
constexpr int ML_QS = 0, ML_KS = 17408, ML_KGT = 34816, ML_VT = 53248, ML_PS = 71680, ML_A = 80896, ML_PM = 89088, ML_BC = 97280, ML_N = 105472, ML_DEN = 105984, ML_SCAN = 106240, ML_END = 106496;
constexpr int ML_HS = 106496;
constexpr int ML_GM = 145408;
constexpr int ML_CW = 140288;
constexpr int ML_QLD = 136, ML_TLD = 72, ML_HLD = 132;
__device__ __forceinline__ int tsw(int row, int s) { return row * ML_TLD + ((((s >> 3) ^ (row >> 3)) & 7) << 3) + (s & 7); }
__device__ __forceinline__ float wave_scan_add(float v, int lane) {
#pragma unroll
    for (int o = 1; o < 64; o <<= 1) { const float u = __shfl_up(v, o); if (lane >= o) v += u; }
    return v;
}
__device__ __forceinline__ float wave_scan_max(float v, int lane) {
#pragma unroll
    for (int o = 1; o < 64; o <<= 1) { const float u = __shfl_up(v, o); if (lane >= o) v = fmaxf(v, u); }
    return v;
}
__device__ __forceinline__ void bf8_to_f32(const u32x4 r, float (&x)[8]) {
    x[0] = __uint_as_float(r.x << 16); x[1] = __uint_as_float(r.x & 0xffff0000u); x[2] = __uint_as_float(r.y << 16); x[3] = __uint_as_float(r.y & 0xffff0000u);
    x[4] = __uint_as_float(r.z << 16); x[5] = __uint_as_float(r.z & 0xffff0000u); x[6] = __uint_as_float(r.w << 16); x[7] = __uint_as_float(r.w & 0xffff0000u);
}
__device__ __forceinline__ void mlstm_item(const Bufs& B, LAS unsigned char* lds, const int b, const int h, const int wave, const int lane, const float* g_mh, const float* conv_w, const float* conv_b) {
    const int tid = wave * 64 + lane;
    const size_t rowb = (size_t)b * SEQ;
    LAS float* As = (LAS float*)(lds + ML_A); LAS float* Pms = (LAS float*)(lds + ML_PM); LAS float* Bcs = (LAS float*)(lds + ML_BC);
    LAS float* Ns = (LAS float*)(lds + ML_N); LAS float* Dens = (LAS float*)(lds + ML_DEN); LAS float* Scan = (LAS float*)(lds + ML_SCAN);
    LAS bf16_t* Qs = (LAS bf16_t*)(lds + ML_QS); LAS bf16_t* Ks = (LAS bf16_t*)(lds + ML_KS); LAS bf16_t* KgT = (LAS bf16_t*)(lds + ML_KGT);
    LAS bf16_t* VT = (LAS bf16_t*)(lds + ML_VT); LAS bf16_t* Ps = (LAS bf16_t*)(lds + ML_PS); LAS float* Hs = (LAS float*)(lds + ML_HS);
    __syncthreads();
    {
        float lf[4], li[4];
#pragma unroll
        for (int i = 0; i < 4; ++i) { lf[i] = B.MF[(rowb + 4 * tid + i) * 4 + h]; li[i] = B.MI[(rowb + 4 * tid + i) * 4 + h]; }
        float c[4]; c[0] = lf[0]; c[1] = c[0] + lf[1]; c[2] = c[1] + lf[2]; c[3] = c[2] + lf[3];
        const float inc = wave_scan_add(c[3], lane);
        if (lane == 63) Scan[wave] = inc;
        __syncthreads();
        float off = inc - c[3];
        for (int w = 0; w < wave; ++w) off += Scan[w];
        float av[4], mx[4];
#pragma unroll
        for (int i = 0; i < 4; ++i) { const float bc = off + c[i]; Bcs[4 * tid + i] = bc; av[i] = li[i] - bc; As[4 * tid + i] = av[i]; }
        mx[0] = av[0]; mx[1] = fmaxf(mx[0], av[1]); mx[2] = fmaxf(mx[1], av[2]); mx[3] = fmaxf(mx[2], av[3]);
        const float incm = wave_scan_max(mx[3], lane);
        __syncthreads();
        if (lane == 63) Scan[wave] = incm;
        __syncthreads();
        float pre = __shfl_up(incm, 1); if (lane == 0) pre = 0.f;
        for (int w = 0; w < wave; ++w) pre = fmaxf(pre, Scan[w]);
        pre = fmaxf(pre, 0.f);
#pragma unroll
        for (int i = 0; i < 4; ++i) Pms[4 * tid + i] = fmaxf(pre, mx[i]);
        if (tid < 128) Ns[tid] = 0.f;
        LAS float* Cw = (LAS float*)(lds + ML_CW);
        for (int idx = tid; idx < 1280; idx += NTHREADS) { const int t = idx / 640, j = (idx % 640) >> 7, c = idx & 127;
            Cw[idx] = j < 4 ? conv_w[j * 1024 + t * 512 + h * 128 + c] : conv_b[t * 512 + h * 128 + c]; }
        if (tid < 128) ((LAS float*)(lds + ML_GM))[tid] = g_mh[h * 128 + tid];
    }
    const int kq = wave >> 2;
    const bf16_t* s0p = (kq ? B.MQ : B.MK) + rowb * 512 + h * 128;
    const bf16_t* s1p = B.MV + rowb * 512 + h * 128;
    u32x4 raw[11];
#define ML_BAR() asm volatile("s_waitcnt lgkmcnt(0)\n\ts_barrier" ::: "memory")
#define ML_LOAD_RAW(t0_) do { const int r0_ = (t0_) + 4 * rq; \
        _Pragma("unroll") for (int i = 0; i < 7; ++i) raw[i] = (r0_ + i - 3 >= 0) ? *(const u32x4*)(s0p + (so + (unsigned)(r0_ + i - 3) * 512u)) : (u32x4){0u, 0u, 0u, 0u}; \
        if (kq) { _Pragma("unroll") for (int i = 0; i < 4; ++i) raw[7 + i] = *(const u32x4*)(s1p + (so + (unsigned)(r0_ + i) * 512u)); } } while (0)
#define ML_CONV(cc_, osc_) do { const LAS float* cwp_ = (const LAS float*)(lds + ML_CW) + (kq ? 0 : 640) + 8 * co; \
        _Pragma("unroll") for (int hq = 0; hq < 2; ++hq) { \
            f32x4v w_[5]; _Pragma("unroll") for (int j = 0; j < 5; ++j) w_[j] = *(const LAS f32x4v*)(cwp_ + j * 128 + 4 * hq); \
            f32x4v x_[7]; _Pragma("unroll") for (int i = 0; i < 7; ++i) { const unsigned lo_ = hq ? raw[i].z : raw[i].x, hi_ = hq ? raw[i].w : raw[i].y; \
                x_[i][0] = __uint_as_float(lo_ << 16); x_[i][1] = __uint_as_float(lo_ & 0xffff0000u); x_[i][2] = __uint_as_float(hi_ << 16); x_[i][3] = __uint_as_float(hi_ & 0xffff0000u); } \
            _Pragma("unroll") for (int rr = 0; rr < 4; ++rr) { f32x4v a_ = w_[4]; _Pragma("unroll") for (int j = 0; j < 4; ++j) a_ += w_[j] * x_[rr + j]; \
                _Pragma("unroll") for (int e = 0; e < 4; ++e) a_[e] = a_[e] * fast_sigmoid(a_[e]) * (osc_); \
                const unsigned p0_ = cvt_pk_bf16(a_[0], a_[1]), p1_ = cvt_pk_bf16(a_[2], a_[3]); if (hq) { cc_[rr].z = p0_; cc_[rr].w = p1_; } else { cc_[rr].x = p0_; cc_[rr].y = p1_; } } } } while (0)
    { const int rq = (tid >> 4) & 15, co = tid & 15; const unsigned so = 8u * (unsigned)co; ML_LOAD_RAW(0); }
    const bf16_t* mob = B.MO + rowb * 512 + h * 128;
    f32x4v Cacc[8];
#pragma unroll
    for (int i = 0; i < 8; ++i) Cacc[i] = (f32x4v){0.f, 0.f, 0.f, 0.f};
    __syncthreads();
#pragma unroll 1
    for (int c = 0; c < SEQ / 64; ++c) {
        const int t0 = c * 64;
        int tl = tid; asm volatile("" : "+v"(tl));
        const int rq = (tl >> 4) & 15, co = tl & 15, l15 = tl & 15, q4 = (tl >> 4) & 3, rp_t = tl >> 3, rp_part = tl & 7; const unsigned so = 8u * (unsigned)co;
        const float Rc = c == 0 ? 0.f : Pms[t0 - 1], Rn = Pms[t0 + 63];
        asm volatile("" : "+v"(raw[0]), "+v"(raw[1]), "+v"(raw[2]), "+v"(raw[3]), "+v"(raw[4]), "+v"(raw[5]), "+v"(raw[6]), "+v"(raw[7]), "+v"(raw[8]), "+v"(raw[9]), "+v"(raw[10]));
        u32x4 cc[4]; ML_CONV(cc, kq ? MLQ_SCALE : 1.f);
        if (kq == 0) {
            float gs[4];
#pragma unroll
            for (int rr = 0; rr < 4; ++rr) { gs[rr] = __expf(As[t0 + 4 * rq + rr] - Rn); *(LAS u32x4*)(Ks + (4 * rq + rr) * ML_QLD + 8 * co) = cc[rr]; }
            float kf[4][8];
#pragma unroll
            for (int rr = 0; rr < 4; ++rr) bf8_to_f32(cc[rr], kf[rr]);
#pragma unroll
            for (int i = 0; i < 8; ++i) { u32x2 w; w.x = cvt_pk_bf16(kf[0][i] * gs[0], kf[1][i] * gs[1]); w.y = cvt_pk_bf16(kf[2][i] * gs[2], kf[3][i] * gs[3]);
                *(LAS u32x2*)(KgT + tsw(8 * co + i, 4 * rq)) = w; }
        } else {
#pragma unroll
            for (int rr = 0; rr < 4; ++rr) *(LAS u32x4*)(Qs + (4 * rq + rr) * ML_QLD + 8 * co) = cc[rr];
            unsigned vv[4][4];
#pragma unroll
            for (int rr = 0; rr < 4; ++rr) { vv[rr][0] = raw[7 + rr].x; vv[rr][1] = raw[7 + rr].y; vv[rr][2] = raw[7 + rr].z; vv[rr][3] = raw[7 + rr].w; }
#pragma unroll
            for (int i = 0; i < 8; ++i) { const int wd = i >> 1; u32x2 w;
                if (i & 1) { w.x = (vv[0][wd] >> 16) | (vv[1][wd] & 0xffff0000u); w.y = (vv[2][wd] >> 16) | (vv[3][wd] & 0xffff0000u); }
                else       { w.x = (vv[0][wd] & 0xffffu) | (vv[1][wd] << 16);     w.y = (vv[2][wd] & 0xffffu) | (vv[3][wd] << 16); }
                *(LAS u32x2*)(VT + tsw(8 * co + i, 4 * rq)) = w; }
        }
        ML_BAR();
        {
            const int ti = wave >> 1;
#pragma unroll
            for (int jj = 0; jj < 2; ++jj) { const int sj = 2 * (wave & 1) + jj;
                f32x4v acc = {0.f, 0.f, 0.f, 0.f};
#pragma unroll
                for (int ks = 0; ks < 4; ++ks) { const bf16x8 af = *(const LAS bf16x8*)(Qs + (16 * ti + l15) * ML_QLD + 32 * ks + 8 * q4), bfr = *(const LAS bf16x8*)(Ks + (16 * sj + l15) * ML_QLD + 32 * ks + 8 * q4);
                    acc = __builtin_amdgcn_mfma_f32_16x16x32_bf16(af, bfr, acc, 0, 0, 0); }
                const int s = 16 * sj + l15; const float as = As[t0 + s];
#pragma unroll
                for (int r = 0; r < 4; ++r) { const int t = 16 * ti + 4 * q4 + r; const float p = s <= t ? acc[r] * __expf(as - Pms[t0 + t]) : 0.f; Ps[t * ML_TLD + s] = f2bf(p); }
            }
        }
        ML_BAR();
        {
            const int t = tid >> 3, part = tid & 7; float qn = 0.f, ps = 0.f;
            float qv[8], qw[8]; bf8_to_f32(*(const LAS u32x4*)(Qs + t * ML_QLD + 16 * part), qv); bf8_to_f32(*(const LAS u32x4*)(Qs + t * ML_QLD + 16 * part + 8), qw);
            const f32x4v n0 = *(const LAS f32x4v*)(Ns + 16 * part), n1 = *(const LAS f32x4v*)(Ns + 16 * part + 4), n2 = *(const LAS f32x4v*)(Ns + 16 * part + 8), n3 = *(const LAS f32x4v*)(Ns + 16 * part + 12);
#pragma unroll
            for (int i = 0; i < 4; ++i) qn += qv[i] * n0[i] + qv[4 + i] * n1[i] + qw[i] * n2[i] + qw[4 + i] * n3[i];
            float pv8[8]; bf8_to_f32(*(const LAS u32x4*)(Ps + t * ML_TLD + 8 * part), pv8);
#pragma unroll
            for (int i = 0; i < 8; ++i) ps += pv8[i];
            qn += __shfl_xor(qn, 1); qn += __shfl_xor(qn, 2); qn += __shfl_xor(qn, 4);
            ps += __shfl_xor(ps, 1); ps += __shfl_xor(ps, 2); ps += __shfl_xor(ps, 4);
            if (part == 0) { const float den = __expf(Rc - Pms[t0 + t]) * qn + ps; Dens[t] = 1.f / fmaxf(fabsf(den), __expf(-(Bcs[t0 + t] + Pms[t0 + t]))); }
        }
        f32x4v no[4];
#pragma unroll
        for (int ti = 0; ti < 4; ++ti) no[ti] = (f32x4v){0.f, 0.f, 0.f, 0.f};
        if (c > 0) {
#pragma unroll
            for (int kk = 0; kk < 4; ++kk) {
                u32x4 cb4; cb4.x = cvt_pk_bf16(Cacc[2 * kk][0], Cacc[2 * kk][1]); cb4.y = cvt_pk_bf16(Cacc[2 * kk][2], Cacc[2 * kk][3]); cb4.z = cvt_pk_bf16(Cacc[2 * kk + 1][0], Cacc[2 * kk + 1][1]); cb4.w = cvt_pk_bf16(Cacc[2 * kk + 1][2], Cacc[2 * kk + 1][3]);
                const bf16x8 cfrag = __builtin_bit_cast(bf16x8, cb4);
#pragma unroll
                for (int ti = 0; ti < 4; ++ti) { const LAS bf16_t* qp = Qs + (16 * ti + l15) * ML_QLD + 32 * kk + 4 * q4;
                    const u32x2 lo = *(const LAS u32x2*)qp, hi = *(const LAS u32x2*)(qp + 16);
                    u32x4 x; x.x = lo.x; x.y = lo.y; x.z = hi.x; x.w = hi.y;
                    no[ti] = __builtin_amdgcn_mfma_f32_16x16x32_bf16(__builtin_bit_cast(bf16x8, x), cfrag, no[ti], 0, 0, 0); }
            }
#pragma unroll
            for (int ti = 0; ti < 4; ++ti) { const f32x4v pm4 = *(const LAS f32x4v*)(Pms + t0 + 16 * ti + 4 * q4);
#pragma unroll
                for (int r = 0; r < 4; ++r) no[ti][r] *= __expf(Rc - pm4[r]); }
        }
        const bf16x8 vfr0 = *(const LAS bf16x8*)(VT + tsw(16 * wave + l15, 8 * q4)), vfr1 = *(const LAS bf16x8*)(VT + tsw(16 * wave + l15, 32 + 8 * q4));
#pragma unroll
        for (int ti = 0; ti < 4; ++ti) { const bf16x8 pf0 = *(const LAS bf16x8*)(Ps + (16 * ti + l15) * ML_TLD + 8 * q4), pf1 = *(const LAS bf16x8*)(Ps + (16 * ti + l15) * ML_TLD + 32 + 8 * q4);
            no[ti] = __builtin_amdgcn_mfma_f32_16x16x32_bf16(pf0, vfr0, no[ti], 0, 0, 0); no[ti] = __builtin_amdgcn_mfma_f32_16x16x32_bf16(pf1, vfr1, no[ti], 0, 0, 0); }
        ML_BAR();
        u32x4 mo_cur[2]; { const unsigned moo = (unsigned)((t0 + rp_t) * 512 + 16 * rp_part); mo_cur[0] = *(const u32x4*)(mob + moo); mo_cur[1] = *(const u32x4*)(mob + (moo + 8u)); }
        if (c + 1 < SEQ / 64) ML_LOAD_RAW(t0 + 64);
#pragma unroll
        for (int ti = 0; ti < 4; ++ti)
#pragma unroll
            for (int r = 0; r < 4; ++r) Hs[(16 * ti + 4 * q4 + r) * ML_HLD + 16 * wave + l15] = no[ti][r];
        {
            const float decay = __expf(Rc - Rn);
#pragma unroll
            for (int dt = 0; dt < 8; ++dt) Cacc[dt] = Cacc[dt] * decay;
#pragma unroll
            for (int dt = 0; dt < 8; ++dt) { const bf16x8 kf0 = *(const LAS bf16x8*)(KgT + tsw(16 * dt + l15, 8 * q4)), kf1 = *(const LAS bf16x8*)(KgT + tsw(16 * dt + l15, 32 + 8 * q4));
                Cacc[dt] = __builtin_amdgcn_mfma_f32_16x16x32_bf16(kf0, vfr0, Cacc[dt], 0, 0, 0); Cacc[dt] = __builtin_amdgcn_mfma_f32_16x16x32_bf16(kf1, vfr1, Cacc[dt], 0, 0, 0); }
            { const int d = tid >> 2, part = tid & 3; float kv[8], kw[8]; bf8_to_f32(*(const LAS u32x4*)(KgT + tsw(d, 16 * part)), kv); bf8_to_f32(*(const LAS u32x4*)(KgT + tsw(d, 16 * part + 8)), kw);
              float s = 0.f;
#pragma unroll
              for (int i = 0; i < 8; ++i) s += kv[i] + kw[i];
              s += __shfl_xor(s, 1); s += __shfl_xor(s, 2);
              if (part == 0) Ns[d] = decay * Ns[d] + s; }
        }
        ML_BAR();
        {
            const int t = tid >> 3, part = tid & 7; const float inv = Dens[t];
            const LAS f32x4v* hp = (const LAS f32x4v*)(Hs + t * ML_HLD + 16 * part);
            f32x4v hq[4]; float sq = 0.f;
#pragma unroll
            for (int i = 0; i < 4; ++i) { hq[i] = hp[i] * inv; sq += dot4(hq[i]); }
            sq += __shfl_xor(sq, 1); sq += __shfl_xor(sq, 2); sq += __shfl_xor(sq, 4);
            const float rs = rsqrtf(sq * (1.f / 128.f) + EPS);
            const size_t row = rowb + t0 + t;
            float mo[8], mo2[8];
            bf8_to_f32(mo_cur[0], mo); bf8_to_f32(mo_cur[1], mo2);
            f32x4v o0, o1, o2, o3;
            const LAS f32x4v* gp = (const LAS f32x4v*)(lds + ML_GM) + 4 * part; const f32x4v g0 = gp[0], g1 = gp[1], g2 = gp[2], g3 = gp[3];
#pragma unroll
            for (int i = 0; i < 4; ++i) { o0[i] = hq[0][i] * rs * g0[i] * mo[i]; o1[i] = hq[1][i] * rs * g1[i] * mo[4 + i]; o2[i] = hq[2][i] * rs * g2[i] * mo2[i]; o3[i] = hq[3][i] * rs * g3[i] * mo2[4 + i]; }
            bf16_t* op = B.MIX + row * 1024 + 512 + h * 128 + 16 * part;
            *(u32x4*)op = pack8(o0, o1); *(u32x4*)(op + 8) = pack8(o2, o3);
        }
    }
#undef ML_LOAD_RAW
#undef ML_CONV
#undef ML_BAR
}

__device__ __forceinline__ void phase_idxml(const Args& a, const Bufs& B, LAS unsigned char* lds, int L, int rep, int bid, int G, int wave, int lane, bool grp) {
    const int x = grp ? (bid & 7) : 0, rank = grp ? (bid >> 3) : bid, nrank = grp ? 32 : G, dsh = grp ? 1 : 4, bb = x << dsh, nml = 4 << dsh, nit = 128 << dsh;
#pragma unroll 1
    for (int item = rank; item < nml; item += nrank) mlstm_item(B, lds, bb + (item >> 2), item & 3, wave, lane, a.in[15] + L * 512, a.in[11] + (size_t)L * 4 * 1024, a.in[12] + L * 1024);
    { unsigned m1 = ~0u; asm volatile("" : "+s"(m1)); lane = (int)__builtin_amdgcn_mbcnt_hi(m1, __builtin_amdgcn_mbcnt_lo(m1, 0u)); }
    unsigned* qctr = (unsigned*)(a.ws + WS_CTL) + 220000 + 64 * (8 * (L + 2 * rep) + x);
    volatile LAS int* slot = (volatile LAS int*)(lds + LDS_BYTES - 128);
    const bool ldr = (wave == 0) && (lane == 0);
    __syncthreads();
    if (ldr) slot[0] = (int)__hip_atomic_fetch_add(qctr, 1u, __ATOMIC_RELAXED, __HIP_MEMORY_SCOPE_AGENT);
    __syncthreads();
    int it = __builtin_amdgcn_readfirstlane(slot[0]), cur = 0;
    IdxPre P, Pn;
    if (it < nit) idx_preload(P, B, bb + (it & ((1 << dsh) - 1)), 127 - (it >> dsh), wave, lane);
    while (it < nit) {
        int nxt = 0;
        if (ldr) nxt = (int)__hip_atomic_fetch_add(qctr, 1u, __ATOMIC_RELAXED, __HIP_MEMORY_SCOPE_AGENT);
        it = idx_wg_item(B, lds, bb + (it & ((1 << dsh) - 1)), 127 - (it >> dsh), wave, lane, P, Pn, slot + 1 + cur, ldr, nxt, dsh, bb);
        P = Pn; cur ^= 1;
    }
}
__device__ __forceinline__ void phase_mix(const Args& a, const Bufs& B, LAS unsigned char* lds, int L, int rep, int bid, int G, int wave, int lane, bool grp) {
#ifndef PROBE_ML
#define PROBE_ML 1
#endif
#ifndef PROBE_ATT
#define PROBE_ATT 1
#endif
#ifdef PROBE_SKIP
    const bool pfx = (a.bar_slot == 0);
#else
    const bool pfx = false;
#endif
#ifndef PROBE_SKIP
#define PROBE_SKIP 0
#endif
    (void)pfx;
#pragma unroll 1
    for (int r = 0; r < PROBE_ATT; ++r) {
        if (pfx && PROBE_SKIP == 1) break;
        const int x = grp ? (bid & 7) : 0, dsh = grp ? 1 : 4, bb = x << dsh, nit = 32 << dsh;
        unsigned* qctr = (unsigned*)(a.ws + WS_CTL) + 200000 + 64 * (8 * (L + 2 * r) + x);
        for (;;) {
            int so = LDS_BYTES - 128; unsigned m1 = ~0u; asm volatile("" : "+s"(so), "+s"(m1));
            volatile LAS int* slot = (volatile LAS int*)(lds + so); lane = (int)__builtin_amdgcn_mbcnt_hi(m1, __builtin_amdgcn_mbcnt_lo(m1, 0u));
            __syncthreads();
            if (wave == 0 && lane == 0) slot[0] = (int)__hip_atomic_fetch_add(qctr, 1u, __ATOMIC_RELAXED, __HIP_MEMORY_SCOPE_AGENT);
            __syncthreads();
            const int it = __builtin_amdgcn_readfirstlane(slot[0]);
            if (it >= nit) break;
            const int b = bb + (it & ((1 << dsh) - 1)), qb = 31 - (it >> dsh);
            att_wg_item(B, lds, b, qb, wave, lane);
        }
    }
}
constexpr int PH_PER_LAYER = 9, PH_TOTAL = 1 + DEPTH * PH_PER_LAYER;
__host__ __device__ __forceinline__ Bufs make_bufs(unsigned char* ws, float* out) {
    Bufs B;
    B.HB = (bf16_t*)(ws + WS_HB); B.SS = (float*)(ws + WS_SS); B.ROPE = (float*)(ws + WS_ROPE); B.CQ = (bf16_t*)(ws + WS_CQ); B.CQSS = (float*)(ws + WS_CQSS);
    B.IW = (float*)(ws + WS_IW); B.MI = (float*)(ws + WS_MI); B.MF = (float*)(ws + WS_MF); B.K = (bf16_t*)(ws + WS_K); B.VT = (bf16_t*)(ws + WS_VT);
    B.IK = (bf16_t*)(ws + WS_IK); B.SEL = (unsigned*)(ws + WS_SEL); B.Q = (bf16_t*)(ws + WS_Q); B.IQ = (bf16_t*)(ws + WS_IQ); B.MQ = (bf16_t*)(ws + WS_MQ);
    B.MK = (bf16_t*)(ws + WS_MK); B.MV = (bf16_t*)(ws + WS_MV); B.MO = (bf16_t*)(ws + WS_MO); B.MIX = (bf16_t*)((unsigned char*)out + 64 * MiB); B.PW0 = (bf16_t*)(ws + WS_PW0); B.PW1 = (bf16_t*)(ws + WS_PW1) - (size_t)PW_SPLIT_PM * 256 * DM;
    B.PB = (bf16_t*)(ws + WS_PB); B.U = (bf16_t*)(ws + WS_U);
    return B;
}

#ifndef REPEAT_MASK
#define REPEAT_MASK 0
#endif
#define PH_REP(k) for (int rep_ = 0; rep_ < (((REPEAT_MASK >> (k)) & 1) ? 2 : 1); ++rep_)
#define PH_IN(p) (lo <= (p) && (p) < hi)
#define PH_SYNC(p) do { if ((p) > lo) xcd_barrier(bar, leader); } while (0)
#define PH_GSYNC(p, idx, arr, wt) do { if ((p) > lo) { const unsigned gm_ = (unsigned)__builtin_amdgcn_readfirstlane((int)bar.st[2]); if (gm_ & 1u) grp_barrier((unsigned*)(a.ws + WS_CTL), bar, gm_, (unsigned)(L * 7 + (idx)), leader, (arr), (wt)); else xcd_barrier(bar, leader); } } while (0)
template <int L>
__device__ __forceinline__ void layer_phases(const Args& a, LAS unsigned char* lds, const XcdBarrier& bar, const int wave, const int lo, const int hi) {
    constexpr int pb = 1 + L * PH_PER_LAYER;
    const int G = gridDim.x, bid = blockIdx.x; const bool leader = (wave == 0) && (__lane_id() == 0);
    if (PH_IN(pb + 0)) { PH_SYNC(pb + 0);
        if (L == 0) {
            const bool use = (gridDim.x == 256u && lo == 0); unsigned* ctl = (unsigned*)(a.ws + WS_CTL);
            if (wave == 0) { unsigned m1 = ~0u; asm volatile("" : "+s"(m1)); const int ln = (int)__builtin_amdgcn_mbcnt_hi(m1, __builtin_amdgcn_mbcnt_lo(m1, 0u));
                const unsigned id = use ? xb_ld(&ctl[GB_XID + (blockIdx.x & 7) + 8 * (ln & 31)]) : 0u; const bool same = (id == xb_xcc_id() + 1u); if (ln == 0) bar.st[2] = use ? (__all(same) ? 3u : 1u) : 0u; }
            __syncthreads();
        }
        PH_REP(0) {
        const Bufs B = make_bufs(a.ws, a.out); unsigned char* wb = a.ws + WS_W + (size_t)L * W_LSTRIDE; pg8::StaticOrder S;
        pg8::Gemm g{(const bf16_t*)a.out, (const bf16_t*)(wb + WO_IN), M, NPROJ, DM}; S.init(M, NPROJ, G, bid);
        EpiProj E{B, B.SS, a.in[9] + L * 64, a.in[10] + L * 64, a.in[13] + L * 4, a.in[14] + L * 4}; pg8::gemm_phase(lds, g, S, E, wave); } }
    if (PH_IN(pb + 1)) { PH_GSYNC(pb + 1, 1, -1, -1); PH_REP(1) {
        const Bufs B = make_bufs(a.ws, a.out); unsigned char* wb = a.ws + WS_W + (size_t)L * W_LSTRIDE; pg8::StaticOrder S;
        pg8::Gemm g{B.CQ, (const bf16_t*)(wb + WO_QUP), M, 1024, QR}; S.init(M, 1024, G, bid);
        EpiQup E{B, a.in[8] + L * 64, (const int*)a.in[2]}; pg8::gemm_phase(lds, g, S, E, wave); } }
    if (PH_IN(pb + 2)) { PH_GSYNC(pb + 2, 2, -1, -1); PH_REP(2) {
        const Bufs B = make_bufs(a.ws, a.out); phase_idxml(a, B, lds, L, rep_, bid, G, wave, (int)__lane_id(), (__builtin_amdgcn_readfirstlane((int)bar.st[2]) & 1) != 0); } }
    if (PH_IN(pb + 3)) { PH_GSYNC(pb + 3, 3, -1, -1); PH_REP(3) {
        const Bufs B = make_bufs(a.ws, a.out);
        phase_mix(a, B, lds, L, rep_, bid, G, wave, (int)__lane_id(), (__builtin_amdgcn_readfirstlane((int)bar.st[2]) & 1) != 0);
        } }
    if (PH_IN(pb + 4)) { PH_GSYNC(pb + 4, 4, L, -1); PH_REP(4) {
        const Bufs B = make_bufs(a.ws, a.out); unsigned char* wb = a.ws + WS_W + (size_t)L * W_LSTRIDE; pg8::StaticOrder S;
        pg8::Gemm g{B.MIX, (const bf16_t*)(wb + WO_OUT), M, DM, DM}; S.init(M, DM, G, bid);
#ifdef PROBE_WOUT
        { EpiRes E0{L == 0 ? a.in[0] : a.out, (float*)B.U, B.U + (size_t)M * 2048, B.SS + (size_t)2 * M * 16}; pg8::gemm_phase(lds, g, S, E0, wave); }
#endif
        { EpiResB<false> E{(const bf16_t*)a.out, B.HB, B.SS + (size_t)M * 16}; pg8::gemm_phase(lds, g, S, E, wave); } } }
    if (PH_IN(pb + 5)) { PH_GSYNC(pb + 5, 5, (L + 1 < DEPTH) ? -1 : 2, L); PH_REP(5) {
        const Bufs B = make_bufs(a.ws, a.out); unsigned char* wb = a.ws + WS_W + (size_t)L * W_LSTRIDE; pg8::StaticOrder S;
        pg8::Gemm g{B.HB, (const bf16_t*)(wb + WO_F1), M, DFF, DM}; S.init(M, DFF, G, bid);
        EpiFF1 E{B.SS + (size_t)M * 16, B.U}; pg8::gemm_phase(lds, g, S, E, wave); } }
    if (PH_IN(pb + 6)) { PH_GSYNC(pb + 6, 6, -1, -1); PH_REP(6) {
        const Bufs B = make_bufs(a.ws, a.out); unsigned char* wb = a.ws + WS_W + (size_t)L * W_LSTRIDE; pg8::StaticOrder S;
        pg8::Gemm g{B.U, (const bf16_t*)(wb + WO_F2), M, DM, DFF}; S.init(M, DM, G, bid); S.rev = true;
        EpiResB<false> E{B.HB, B.HB, B.SS + (size_t)2 * M * 16}; pg8::gemm_phase<EpiResB<false>, true>(lds, g, S, E, wave); } }
    if (PH_IN(pb + 7)) { PH_REP(7) {
        const Bufs B = make_bufs(a.ws, a.out); unsigned char* wb = a.ws + WS_W + (size_t)L * W_LSTRIDE; pg8::StaticOrder S;
        pg8::Gemm g{B.PB + (size_t)L * M * PLE, (const bf16_t*)(wb + WO_P), M, DM, PLE}; S.init(M, DM, G, bid);
        EpiPW E{B.PW0, B.PW1}; pg8::gemm_phase(lds, g, S, E, wave); } }
    if (PH_IN(pb + 8)) { PH_GSYNC(pb + 8, 7, -1, (L + 1 < DEPTH) ? -1 : 2); PH_REP(8) {
        const Bufs B = make_bufs(a.ws, a.out); unsigned char* wb = a.ws + WS_W + (size_t)L * W_LSTRIDE; pg8::StaticOrder S;
        pg8::Gemm g{B.HB, (const bf16_t*)(wb + WO_G), M, DM, DM}; S.init(M, DM, G, bid);
        if (L + 1 < DEPTH) { EpiGateB<false> E{B.SS + (size_t)2 * M * 16, a.in[22] + L * DM, B.PW0, B.PW1, B.HB, nullptr, (bf16_t*)a.out, B.SS}; pg8::gemm_phase(lds, g, S, E, wave); }
        else { EpiGateB<true> E{B.SS + (size_t)2 * M * 16, a.in[22] + L * DM, B.PW0, B.PW1, B.HB, a.out, nullptr, nullptr}; pg8::gemm_phase(lds, g, S, E, wave); } } }
}

__global__ void __launch_bounds__(NTHREADS, 2) mega(Args a) {
    extern __shared__ __attribute__((aligned(16))) unsigned char lds_raw[];
    LAS unsigned char* lds = (LAS unsigned char*)lds_raw;
    const int wave = __builtin_amdgcn_readfirstlane((int)(threadIdx.x >> 6));
    const bool leader = (wave == 0) && (__lane_id() == 0);
    volatile LAS unsigned* st = (volatile LAS unsigned*)(lds + LDS_BYTES - 64);
    if (leader) { st[0] = 0u; st[1] = 0u; }
    __syncthreads();
    const XcdBarrier bar = xcd_barrier_post((unsigned*)(a.ws + WS_CTL) + a.bar_slot * XCD_BAR_WORDS, st, leader);
    cg::this_grid().sync();
    const int lo = a.ph_lo, hi = a.ph_hi;
    if (leader) { unsigned xv = xb_xcc_id() + 1u; (void)xb_add((unsigned*)(a.ws + WS_CTL) + GB_XID + blockIdx.x, xv); }
#ifdef PROBE_BAR
#pragma unroll 1
    for (int i = 0; i < PROBE_BAR; ++i) xcd_barrier(bar, leader);
#endif
#ifndef PROBE_P0
#define PROBE_P0 1
#endif
    if (PH_IN(0)) for (int rep_ = 0; rep_ < PROBE_P0; ++rep_) { const Bufs B = make_bufs(a.ws, a.out); phase_prologue(a, B, lds, blockIdx.x * NWAVES + wave, gridDim.x * NWAVES, wave, (int)__lane_id()); }
    layer_phases<0>(a, lds, bar, wave, lo, hi);
    layer_phases<1>(a, lds, bar, wave, lo, hi);
}

static int g_grid = 0;
static int g_slot = 0;
static void launch_mega(const Args& base, int lo, int hi, hipStream_t stream) {
    Args a = base; a.ph_lo = lo; a.ph_hi = hi; a.bar_slot = g_slot++;
    void* args[] = {&a};
    hipError_t e = hipLaunchCooperativeKernel((const void*)mega, dim3(g_grid), dim3(NTHREADS), args, LDS_BYTES, stream);
    if (e != hipSuccess) fprintf(stderr, "kernel_launch: cooperative launch [%d,%d) failed: %s (grid %d)\n", lo, hi, hipGetErrorString(e), g_grid);
}

extern "C" void kernel_launch(void* const* d_in, const int* in_sizes, int n_in, void* d_out, int out_size, void* d_ws, size_t ws_size, hipStream_t stream) {
    if (n_in != 24 || ws_size < WS_END) { fprintf(stderr, "kernel_launch: unexpected n_in %d or ws %zu\n", n_in, ws_size); return; }
    if (g_grid == 0) {
        int dev = 0, cus = 0, per_cu = 0;
        hipGetDevice(&dev); hipDeviceGetAttribute(&cus, hipDeviceAttributeMultiprocessorCount, dev);
        if (hipFuncSetAttribute((const void*)mega, hipFuncAttributeMaxDynamicSharedMemorySize, LDS_BYTES) != hipSuccess) { fprintf(stderr, "kernel_launch: hipFuncSetAttribute failed\n"); g_grid = -1; return; }
        if (hipOccupancyMaxActiveBlocksPerMultiprocessor(&per_cu, (const void*)mega, NTHREADS, LDS_BYTES) != hipSuccess || per_cu < 1) { fprintf(stderr, "kernel_launch: occupancy query failed (%d)\n", per_cu); g_grid = -1; return; }
        g_grid = cus * per_cu;
        fprintf(stderr, "kernel_launch: %d CUs x %d blocks/CU -> grid %d\n", cus, per_cu, g_grid);
    }
    if (g_grid < 0) return;
    float* OUT = (float*)d_out; unsigned char* ws = (unsigned char*)d_ws;
    Args a{};
    for (int i = 0; i < 24; ++i) a.in[i] = (const float*)d_in[i];
    a.out = OUT; a.ws = ws;

    g_slot = 0;
    if (hipMemsetAsync(ws + WS_CTL, 0, 1 * MiB, stream) != hipSuccess) { fprintf(stderr, "kernel_launch: memset failed\n"); return; }
#ifdef PROBE_PREFIX
    launch_mega(a, 0, PROBE_PREFIX, stream);
    if (hipMemsetAsync(ws + WS_CTL, 0, 1 * MiB, stream) != hipSuccess) return;
#endif
    launch_mega(a, 0, PH_TOTAL, stream);
}
```
